# Optimizing an MI355X kernel written in HIP

```python
import math
import jax, jax.numpy as jnp
from jax import lax
import numpy as np

D_MODEL = 1024
BATCH = 16
SEQ = 2048
DEPTH = 1

HEAD_DIM = 64
N_DIFF_HEADS = 4
DIFF_V_DIM = 2 * HEAD_DIM
N_DIL_HEADS = 8
DIL_PATTERNS = ((128, 1), (512, 4), (2048, 16))
Q_BLOCK = 128
D_FF = 2816
RMS_EPS = 1e-6
LAMBDA_STD = 0.1

DIFF_QK_WIDTH = N_DIFF_HEADS * 2 * HEAD_DIM
DIFF_V_WIDTH = N_DIFF_HEADS * DIFF_V_DIM
DIL_WIDTH = N_DIL_HEADS * HEAD_DIM
IN_PROJ_WIDTH = 2 * DIFF_QK_WIDTH + DIFF_V_WIDTH + 3 * DIL_WIDTH
MIX_WIDTH = DIFF_V_WIDTH + DIL_WIDTH
N_ALIBI_HEADS = N_DIFF_HEADS + N_DIL_HEADS

kernel_name = "hybrid_diffattn_dilated_macaron_layer"


def rms_norm(x, g):
    xf = x.astype(jnp.float32)
    y = xf * lax.rsqrt(jnp.mean(xf * xf, axis=-1, keepdims=True) + RMS_EPS)
    return (y * g.astype(jnp.float32)).astype(x.dtype)


def swiglu(x, w_gate, w_up, w_down):
    return (jax.nn.silu(x @ w_gate) * (x @ w_up)) @ w_down


def alibi_slopes():
    all_s = 2.0 ** (-8.0 * jnp.arange(1, N_ALIBI_HEADS + 1, dtype=jnp.float32) / N_ALIBI_HEADS)
    diff_idx = np.arange(0, N_ALIBI_HEADS, N_ALIBI_HEADS // N_DIFF_HEADS)
    dil_idx = np.setdiff1d(np.arange(N_ALIBI_HEADS), diff_idx)
    return all_s[diff_idx], all_s[dil_idx]


def lambda_init_fn(layer):
    return 0.8 - 0.6 * math.exp(-0.3 * layer)


def diff_attention(q, k, v, slopes, lam, lam_init, subln_g):
    B, S, H = q.shape[0], q.shape[1], q.shape[2]
    nb = S // Q_BLOCK
    scale = HEAD_DIM ** -0.5
    qb = q.reshape(B, nb, Q_BLOCK, H, 2, HEAD_DIM).transpose(1, 0, 2, 3, 4, 5)
    pos_k = jnp.arange(S)

    def block(args):
        qi, bi = args
        s = jnp.einsum('bqhcd,bkhcd->bhcqk', qi, k, preferred_element_type=jnp.float32) * scale
        pos_q = bi * Q_BLOCK + jnp.arange(Q_BLOCK)
        dist = pos_q[:, None] - pos_k[None, :]
        bias = -slopes[:, None, None] * dist.astype(jnp.float32)[None]
        s = s + bias[None, :, None]
        s = jnp.where((dist >= 0)[None, None, None], s, -jnp.inf)
        p = jax.nn.softmax(s, axis=-1)
        a = p[:, :, 0] - lam * p[:, :, 1]
        return jnp.einsum('bhqk,bkhd->bqhd', a.astype(v.dtype), v)

    o = lax.map(block, (qb, jnp.arange(nb)))
    o = o.transpose(1, 0, 2, 3, 4).reshape(B, S, H, DIFF_V_DIM)
    o = rms_norm(o, subln_g) * (1.0 - lam_init)
    return o.reshape(B, S, H * DIFF_V_DIM)


def dilated_pattern(q, k, v, slopes, window, dil):
    B, S, H, D = q.shape
    L = S // dil
    n_win = window // dil
    Lp = -(-L // Q_BLOCK) * Q_BLOCK
    nb = Lp // Q_BLOCK
    pad = Lp - L

    def to_blocks(a):
        a = a.reshape(B, L, dil, H, D).transpose(0, 2, 1, 3, 4)
        a = jnp.pad(a, ((0, 0), (0, 0), (0, pad), (0, 0), (0, 0)))
        return a.reshape(B, dil, nb, Q_BLOCK, H, D)

    def with_prev(a):
        prev = jnp.pad(a, ((0, 0), (0, 0), (1, 0), (0, 0), (0, 0), (0, 0)))[:, :, :-1]
        return jnp.concatenate([prev, a], axis=3)

    qb = to_blocks(q)
    kc = with_prev(to_blocks(k))
    vc = with_prev(to_blocks(v))
    s = jnp.einsum('brnqhd,brnkhd->brnhqk', qb, kc, preferred_element_type=jnp.float32) * (D ** -0.5)
    j = jnp.arange(Q_BLOCK)
    c = jnp.arange(2 * Q_BLOCK)
    dsub = (Q_BLOCK + j)[:, None] - c[None, :]
    key_idx = jnp.arange(nb)[:, None, None] * Q_BLOCK - Q_BLOCK + c[None, None, :]
    valid = (dsub >= 0)[None] & (dsub <= n_win)[None] & (key_idx >= 0)
    bias = -slopes[:, None, None] * (dsub * dil).astype(jnp.float32)[None]
    s = s + bias[None, None, None]
    s = jnp.where(valid[None, None, :, None], s, -jnp.inf)
    m = jnp.max(s, axis=-1, keepdims=True)
    e = jnp.exp(s - m)
    l = jnp.sum(e, axis=-1, keepdims=True)
    o = jnp.einsum('brnhqk,brnkhd->brnqhd', (e / l).astype(v.dtype), vc)
    lse = (m + jnp.log(l))[..., 0]
    o = o.reshape(B, dil, Lp, H, D)[:, :, :L].transpose(0, 2, 1, 3, 4).reshape(B, S, H, D)
    lse = lse.transpose(0, 1, 2, 4, 3).reshape(B, dil, Lp, H)[:, :, :L].transpose(0, 2, 1, 3).reshape(B, S, H)
    return o, lse


def dilated_attention(q, k, v, slopes):
    B, S, H, D = q.shape
    outs, lses = [], []
    for window, dil in DIL_PATTERNS:
        o, lse = dilated_pattern(q, k, v, slopes, window, dil)
        outs.append(o)
        lses.append(lse)
    w = jax.nn.softmax(jnp.stack(lses, axis=0), axis=0)
    o = sum(w[i][..., None] * outs[i].astype(jnp.float32) for i in range(len(DIL_PATTERNS)))
    return o.astype(q.dtype).reshape(B, S, H * D)


def hybrid_mixer(h, w_in, lam_q1, lam_k1, lam_q2, lam_k2, subln_g, w_out, layer):
    B, S, _ = h.shape
    proj = h @ w_in
    splits = np.cumsum([DIFF_QK_WIDTH, DIFF_QK_WIDTH, DIFF_V_WIDTH, DIL_WIDTH, DIL_WIDTH])
    q_d, k_d, v_d, q_l, k_l, v_l = jnp.split(proj, splits, axis=-1)
    slopes_d, slopes_l = alibi_slopes()
    lam_init = lambda_init_fn(layer)
    lam = (jnp.exp(jnp.sum(lam_q1.astype(jnp.float32) * lam_k1.astype(jnp.float32)))
           - jnp.exp(jnp.sum(lam_q2.astype(jnp.float32) * lam_k2.astype(jnp.float32))) + lam_init)
    o_d = diff_attention(q_d.reshape(B, S, N_DIFF_HEADS, 2, HEAD_DIM),
                         k_d.reshape(B, S, N_DIFF_HEADS, 2, HEAD_DIM),
                         v_d.reshape(B, S, N_DIFF_HEADS, DIFF_V_DIM),
                         slopes_d, lam, lam_init, subln_g)
    o_l = dilated_attention(q_l.reshape(B, S, N_DIL_HEADS, HEAD_DIM),
                            k_l.reshape(B, S, N_DIL_HEADS, HEAD_DIM),
                            v_l.reshape(B, S, N_DIL_HEADS, HEAD_DIM), slopes_l)
    return jnp.concatenate([o_d, o_l], axis=-1) @ w_out


def setup_inputs(seed: int = 0) -> dict:
    key = jax.random.key(seed)
    ks = jax.random.split(key, 24)
    f32 = jnp.float32

    def w(k, fan_in, fan_out):
        return jax.random.normal(k, (DEPTH, fan_in, fan_out), f32) * fan_in ** -0.5

    def gain(k, n):
        return 1.0 + 0.05 * jax.random.normal(k, (DEPTH, n), f32)

    return {
        "x": jax.random.normal(ks[0], (BATCH, SEQ, D_MODEL), f32),
        "ffn1_pre_g": gain(ks[1], D_MODEL),
        "ffn1_w_gate": w(ks[2], D_MODEL, D_FF),
        "ffn1_w_up": w(ks[3], D_MODEL, D_FF),
        "ffn1_w_down": w(ks[4], D_FF, D_MODEL),
        "ffn1_post_g": gain(ks[5], D_MODEL),
        "mix_pre_g": gain(ks[6], D_MODEL),
        "w_in": w(ks[7], D_MODEL, IN_PROJ_WIDTH),
        "lambda_q1": LAMBDA_STD * jax.random.normal(ks[8], (DEPTH, HEAD_DIM), f32),
        "lambda_k1": LAMBDA_STD * jax.random.normal(ks[9], (DEPTH, HEAD_DIM), f32),
        "lambda_q2": LAMBDA_STD * jax.random.normal(ks[10], (DEPTH, HEAD_DIM), f32),
        "lambda_k2": LAMBDA_STD * jax.random.normal(ks[11], (DEPTH, HEAD_DIM), f32),
        "diff_subln_g": gain(ks[12], DIFF_V_DIM),
        "w_out": w(ks[13], MIX_WIDTH, D_MODEL),
        "mix_post_g": gain(ks[14], D_MODEL),
        "ffn2_pre_g": gain(ks[15], D_MODEL),
        "ffn2_w_gate": w(ks[16], D_MODEL, D_FF),
        "ffn2_w_up": w(ks[17], D_MODEL, D_FF),
        "ffn2_w_down": w(ks[18], D_FF, D_MODEL),
        "ffn2_post_g": gain(ks[19], D_MODEL),
    }


def reference(x, ffn1_pre_g, ffn1_w_gate, ffn1_w_up, ffn1_w_down, ffn1_post_g,
              mix_pre_g, w_in, lambda_q1, lambda_k1, lambda_q2, lambda_k2, diff_subln_g,
              w_out, mix_post_g, ffn2_pre_g, ffn2_w_gate, ffn2_w_up, ffn2_w_down, ffn2_post_g):
    for l in range(DEPTH):
        h = swiglu(rms_norm(x, ffn1_pre_g[l]), ffn1_w_gate[l], ffn1_w_up[l], ffn1_w_down[l])
        x = x + 0.5 * rms_norm(h, ffn1_post_g[l])
        h = hybrid_mixer(rms_norm(x, mix_pre_g[l]), w_in[l], lambda_q1[l], lambda_k1[l],
                         lambda_q2[l], lambda_k2[l], diff_subln_g[l], w_out[l], l)
        x = x + rms_norm(h, mix_post_g[l])
        h = swiglu(rms_norm(x, ffn2_pre_g[l]), ffn2_w_gate[l], ffn2_w_up[l], ffn2_w_down[l])
        x = x + 0.5 * rms_norm(h, ffn2_post_g[l])
    return x
```

```cpp
#include <hip/hip_runtime.h>
#include <hip/hip_cooperative_groups.h>
#include <cstdio>
#include <cstdint>
#include <cmath>
namespace cg = cooperative_groups;
namespace pg8 {
#define PG8_LAS __attribute__((address_space(3)))
typedef unsigned short bf16_t;
typedef short bf16x8 __attribute__((ext_vector_type(8)));
typedef float f32x4 __attribute__((ext_vector_type(4)));
typedef unsigned u32x4 __attribute__((ext_vector_type(4)));
constexpr int BM = 256, BK = 64, HALF = 128, HTB = HALF * BK * 2  , STAGE_BYTES = 8 * HTB, NXCD = 8, WGM = 8;

__host__ __device__ __forceinline__ int lds_byte(int r, int c) { const int st = (r >> 4) * 2 + (c >> 5), rr = r & 15, cc = c & 31, ob = rr * 64 + cc * 2; return st * 1024 + (ob ^ (((ob >> 9) & 1) << 5)); }
__host__ __device__ __forceinline__ void stage_rc(int b, int& R, int& C) { const int st = b / 1024, sb = b % 1024, swz = sb ^ (((sb >> 9) & 1) << 5); R = (st >> 1) * 16 + swz / 64; C = (st & 1) * 32 + (swz % 64) / 2; }
__host__ __device__ __forceinline__ int perm32(int rho) { const int n = rho >> 4, i = rho & 15; return 8 * (i >> 2) + 4 * n + (i & 3); }

struct Unit { int pm, pn; };
struct Gemm { const bf16_t* A; const bf16_t* Bt; int M, N, K; };

struct StaticOrder {
    int nM, nN, nwg, G, c;
    __host__ __device__ void init(int M, int N, int G_, int c_) { nM = M / BM; nN = N / BM; nwg = nM * nN; G = G_; c = c_; }
    __host__ __device__ bool next(int i, Unit& u) const {
        const long L = (long)i * G + c; if (L >= nwg) return false;
        int wgid = (int)L; { const int q = nwg / NXCD, r = nwg % NXCD, xcd = wgid % NXCD, off = wgid / NXCD; wgid = (xcd < r ? xcd * (q + 1) : r * (q + 1) + (xcd - r) * q) + off; }
        const int nig = WGM * nN, gid = wgid / nig, fm = gid * WGM, gsz = (nM - fm) < WGM ? (nM - fm) : WGM;
        u.pm = fm + ((wgid % nig) % gsz); u.pn = (wgid % nig) / gsz; return true;
    }
    __device__ __forceinline__ void a_ready(const Unit&) const {}
    __device__ __forceinline__ void done(const Unit&) const {}
};

__device__ __forceinline__ unsigned cvt_pk_bf16(float lo, float hi) { unsigned r; asm volatile("v_cvt_pk_bf16_f32 %0, %1, %2" : "=v"(r) : "v"(lo), "v"(hi)); return r; }
typedef float f32x2 __attribute__((ext_vector_type(2)));
__device__ __forceinline__ f32x2 gelu_pk(f32x2 v) {
    const f32x2 av = __builtin_elementwise_abs(v), d = av * 0.2316418882f + 1.0f;
    f32x2 t; t.x = __builtin_amdgcn_rcpf(d.x); t.y = __builtin_amdgcn_rcpf(d.y);
    f32x2 q = t * 0.5307027145f + (-0.7265760135f); q = q * t + 0.7107068705f; q = q * t + (-0.142248368f); q = q * t + 0.127414796f; q = q * t;
    const f32x2 s = (v * v) * (-0.72134752044f);
    f32x2 e; e.x = __builtin_amdgcn_exp2f(s.x); e.y = __builtin_amdgcn_exp2f(s.y);
    const f32x2 m = v * (q * e), r = v - m;
    f32x2 o; o.x = v.x < 0.f ? m.x : r.x; o.y = v.y < 0.f ? m.y : r.y; return o;
}

template <int ACT  > struct EpiBf16 {
    static constexpr bool PERM = true, AFTER_DRAIN = false; static_assert(ACT == 0 || ACT == 1, "EpiBf16: ACT is 0 (none) or 1 (gelu_pk)");
    bf16_t* O; int ldc; const float* bias; int split_cols; size_t split_stride; float scale0;
    __device__ __forceinline__ void operator()(const f32x4 (&acc)[2][2][4][2], const Unit& u, int wr, int wc, int fr, int fq) const {
        const int row0 = u.pm * BM + wr * 64 + fr; int colt = u.pn * BM; bf16_t* base = O;
        float sc = 1.f; if (split_cols) { const int t = colt / split_cols; base += (size_t)t * split_stride; colt -= t * split_cols; if (t == 0) sc = scale0; }
        const int col0 = colt + wc * 32 + 8 * fq, bcol0 = u.pn * BM + wc * 32 + 8 * fq;
        f32x4 bv[2][2];
#pragma unroll
        for (int bj = 0; bj < 2; ++bj)
#pragma unroll
            for (int n = 0; n < 2; ++n) bv[bj][n] = bias ? *(const f32x4*)(bias + bcol0 + bj * HALF + 4 * n) : (f32x4){0.f, 0.f, 0.f, 0.f};
#pragma unroll
        for (int ai = 0; ai < 2; ++ai)
#pragma unroll
            for (int m = 0; m < 4; ++m) { bf16_t* rowp = base + (size_t)(row0 + ai * HALF + m * 16) * ldc + col0;
#pragma unroll
                for (int bj = 0; bj < 2; ++bj) { f32x4 v0 = acc[ai][bj][m][0] + bv[bj][0], v1 = acc[ai][bj][m][1] + bv[bj][1];
                    if (ACT == 1) { f32x2 a = gelu_pk((f32x2){v0[0], v0[1]}), b = gelu_pk((f32x2){v0[2], v0[3]}), c = gelu_pk((f32x2){v1[0], v1[1]}), d = gelu_pk((f32x2){v1[2], v1[3]});
                        v0 = (f32x4){a.x, a.y, b.x, b.y}; v1 = (f32x4){c.x, c.y, d.x, d.y}; }
                    v0 = v0 * sc; v1 = v1 * sc; u32x4 w; w.x = cvt_pk_bf16(v0[0], v0[1]); w.y = cvt_pk_bf16(v0[2], v0[3]); w.z = cvt_pk_bf16(v1[0], v1[1]); w.w = cvt_pk_bf16(v1[2], v1[3]);
                    *(u32x4*)(rowp + bj * HALF) = w; } }
    }
};
struct EpiSwiglu {
    static constexpr bool PERM = true, AFTER_DRAIN = false;
    bf16_t* O; int ldc; const float* rstd;
    __device__ __forceinline__ static float silu_mul(float g, float u) { return g * __builtin_amdgcn_rcpf(1.0f + __builtin_amdgcn_exp2f(g * -1.4426950408889634f)) * u; }
    __device__ __forceinline__ void operator()(const f32x4 (&acc)[2][2][4][2], const Unit& u, int wr, int wc, int fr, int fq) const {
        const int row0 = u.pm * BM + wr * 64 + fr; const int col0 = u.pn * HALF + wc * 32 + 8 * fq;
#pragma unroll
        for (int ai = 0; ai < 2; ++ai)
#pragma unroll
            for (int m = 0; m < 4; ++m) { bf16_t* rowp = O + (size_t)(row0 + ai * HALF + m * 16) * ldc + col0; const float rs = rstd[row0 + ai * HALF + m * 16];
                const f32x4 g0 = acc[ai][0][m][0] * rs, g1 = acc[ai][0][m][1] * rs, u0 = acc[ai][1][m][0] * rs, u1 = acc[ai][1][m][1] * rs;
                u32x4 w; w.x = cvt_pk_bf16(silu_mul(g0[0], u0[0]), silu_mul(g0[1], u0[1])); w.y = cvt_pk_bf16(silu_mul(g0[2], u0[2]), silu_mul(g0[3], u0[3]));
                w.z = cvt_pk_bf16(silu_mul(g1[0], u1[0]), silu_mul(g1[1], u1[1])); w.w = cvt_pk_bf16(silu_mul(g1[2], u1[2]), silu_mul(g1[3], u1[3]));
                *(u32x4*)rowp = w; }
    }
};
struct EpiF32 {
    static constexpr bool PERM = true, AFTER_DRAIN = false;
    float* O; int ldc;
    __device__ __forceinline__ void operator()(const f32x4 (&acc)[2][2][4][2], const Unit& u, int wr, int wc, int fr, int fq) const {
        const int row0 = u.pm * BM + wr * 64 + fr; const int col0 = u.pn * BM + wc * 32 + 8 * fq;
#pragma unroll
        for (int ai = 0; ai < 2; ++ai)
#pragma unroll
            for (int m = 0; m < 4; ++m) { float* rowp = O + (size_t)(row0 + ai * HALF + m * 16) * ldc + col0;
#pragma unroll
                for (int bj = 0; bj < 2; ++bj) { *(f32x4*)(rowp + bj * HALF) = acc[ai][bj][m][0]; *(f32x4*)(rowp + bj * HALF + 4) = acc[ai][bj][m][1]; } }
    }
};
struct EpiProj {
    static constexpr bool PERM = true, AFTER_DRAIN = false;
    bf16_t* O; int ldc; float qscale; const float* rstd;
    __device__ __forceinline__ void operator()(const f32x4 (&acc)[2][2][4][2], const Unit& u, int wr, int wc, int fr, int fq) const {
        const int row0 = u.pm * BM + wr * 64 + fr; const int col0 = u.pn * BM + wc * 32 + 8 * fq;
        const float sc = (u.pn < 2 || u.pn == 6 || u.pn == 7) ? qscale : 1.0f;
#pragma unroll
        for (int ai = 0; ai < 2; ++ai)
#pragma unroll
            for (int m = 0; m < 4; ++m) { bf16_t* rowp = O + (size_t)(row0 + ai * HALF + m * 16) * ldc + col0; const float rs = sc * rstd[row0 + ai * HALF + m * 16];
#pragma unroll
                for (int bj = 0; bj < 2; ++bj) { const f32x4 v0 = acc[ai][bj][m][0] * rs, v1 = acc[ai][bj][m][1] * rs;
                    u32x4 w; w.x = cvt_pk_bf16(v0[0], v0[1]); w.y = cvt_pk_bf16(v0[2], v0[3]); w.z = cvt_pk_bf16(v1[0], v1[1]); w.w = cvt_pk_bf16(v1[2], v1[3]);
                    *(u32x4*)(rowp + bj * HALF) = w; } }
    }
};
template <class Epi, class Sched, bool ALIGN_EPI = false, bool SP2 = false>
__device__ __forceinline__ void gemm_phase(PG8_LAS unsigned char* lds, const Gemm g, const Sched& S, const Epi& E) {
    const int tid = threadIdx.x, wid = __builtin_amdgcn_readfirstlane(tid >> 6), lane = tid & 63, wr = wid >> 2, wc = wid & 3, fr = lane & 15, fq = lane >> 4;
    const int K = g.K, nt = K / BK;
    unsigned voffA[2], voffB[2];
#pragma unroll
    for (int i = 0; i < 2; ++i) { int R, C; stage_rc(tid * 16 + i * 8192, R, C); const int Rb = Epi::PERM ? ((R & ~31) + perm32(R & 31)) : R;
        voffA[i] = (unsigned)(R * K + C) * 2u; voffB[i] = (unsigned)(Rb * K + C) * 2u; }
    const size_t kstep = (size_t)(BK * 2);
    const size_t hstep = (size_t)HALF * K * 2;
    const size_t tstep = 2 * hstep;
    const unsigned ldsw = (unsigned)wid * 1024u;
    const int aoff = lds_byte(wr * 64 + fr, fq * 8), boff = lds_byte(wc * 32 + fr, fq * 8);
#define PG8_SA(b, h) (((b) * 2 + (h)) * HTB)
#define PG8_SB(b, h) ((4 + (b) * 2 + (h)) * HTB)
#define PG8_STAGE(bufoff, gbase, voff) do { _Pragma("unroll") for (int _i = 0; _i < 2; ++_i) \
        __builtin_amdgcn_global_load_lds((const unsigned*)((const char*)(gbase) + (voff)[_i]), (PG8_LAS unsigned*)(lds + (bufoff) + ldsw + _i * 8192), 16, 0, 0); } while (0)
#define PG8_LDA(dst, b, h) do { _Pragma("unroll") for (int m = 0; m < 4; ++m) _Pragma("unroll") for (int k = 0; k < 2; ++k) dst[m][k] = *(const PG8_LAS bf16x8*)(lds + PG8_SA(b, h) + aoff + m * 2048 + k * 1024); } while (0)
#define PG8_LDB(dst, b, h) do { _Pragma("unroll") for (int n = 0; n < 2; ++n) _Pragma("unroll") for (int k = 0; k < 2; ++k) dst[n][k] = *(const PG8_LAS bf16x8*)(lds + PG8_SB(b, h) + boff + n * 2048 + k * 1024); } while (0)
#define PG8_MMA(ai, bj, At, Bt) do { __builtin_amdgcn_s_setprio(1); _Pragma("unroll") for (int m = 0; m < 4; ++m) _Pragma("unroll") for (int n = 0; n < 2; ++n) _Pragma("unroll") for (int k = 0; k < 2; ++k) \
        acc[ai][bj][m][n] = __builtin_amdgcn_mfma_f32_16x16x32_bf16(Bt[n][k], At[m][k], acc[ai][bj][m][n], 0, 0, 0); __builtin_amdgcn_s_setprio(0); } while (0)
#define PG8_WAIT_V(n) asm volatile("s_waitcnt vmcnt(" #n ")" ::: "memory")
#define PG8_WAIT_L(n) asm volatile("s_waitcnt lgkmcnt(" #n ")" ::: "memory")
#define PG8_BAR __builtin_amdgcn_s_barrier()
#define PG8_SCHED __builtin_amdgcn_sched_barrier(0)
    Unit cur, nxt; int ui = 0;
    if (!S.next(0, cur)) return;
    f32x4 acc[2][2][4][2];
#pragma unroll
    for (int a = 0; a < 2; ++a)
#pragma unroll
        for (int b = 0; b < 2; ++b)
#pragma unroll
            for (int m = 0; m < 4; ++m)
#pragma unroll
                for (int n = 0; n < 2; ++n) acc[a][b][m][n] = (f32x4){0.f, 0.f, 0.f, 0.f};
    bf16x8 At[4][2], B0[2][2], B1[2][2];
    const char* cA = (const char*)g.A + (size_t)cur.pm * tstep; const char* cB = (const char*)g.Bt + (size_t)cur.pn * tstep;
    S.a_ready(cur);
    if constexpr (SP2) {
        PG8_STAGE(PG8_SB(0, 0), cB, voffB); PG8_STAGE(PG8_SB(0, 1), cB + hstep, voffB); PG8_STAGE(PG8_SA(0, 0), cA, voffA); PG8_STAGE(PG8_SA(0, 1), cA + hstep, voffA);
        if (wr == 1) PG8_BAR;
        PG8_WAIT_V(2); PG8_BAR;
        PG8_STAGE(PG8_SB(1, 0), cB + kstep, voffB); PG8_STAGE(PG8_SA(1, 0), cA + kstep, voffA); PG8_STAGE(PG8_SB(1, 1), cB + hstep + kstep, voffB);
        PG8_WAIT_V(6); PG8_BAR;
    } else {
        PG8_STAGE(PG8_SB(0, 0), cB, voffB); PG8_STAGE(PG8_SA(0, 0), cA, voffA); PG8_STAGE(PG8_SB(0, 1), cB + hstep, voffB); PG8_STAGE(PG8_SA(0, 1), cA + hstep, voffA);
        if (wr == 1) PG8_BAR;
        PG8_WAIT_V(4); PG8_BAR;
        PG8_STAGE(PG8_SB(1, 0), cB + kstep, voffB); PG8_STAGE(PG8_SA(1, 0), cA + kstep, voffA); PG8_STAGE(PG8_SB(1, 1), cB + hstep + kstep, voffB);
        PG8_WAIT_V(6); PG8_BAR;
    }
    for (;;) {
        const bool has_next = S.next(ui + 1, nxt);
        const char* nA = has_next ? (const char*)g.A + (size_t)nxt.pm * tstep : cA; const char* nB = has_next ? (const char*)g.Bt + (size_t)nxt.pn * tstep : cB;
        for (int t = 0; t < nt; t += 2) {
            const bool last = (t == nt - 2);
            const char* a1 = cA + (size_t)(t + 1) * kstep;
            const char* a2 = last ? nA : cA + (size_t)(t + 2) * kstep; const char* b2 = last ? nB : cB + (size_t)(t + 2) * kstep;
            const char* a3 = a2 + kstep; const char* b3 = b2 + kstep;
            if (last && has_next) S.a_ready(nxt);
            if constexpr (SP2) {
            PG8_LDB(B0, 0, 0); PG8_LDB(B1, 0, 1); PG8_SCHED; PG8_LDA(At, 0, 0); PG8_STAGE(PG8_SA(1, 1), a1 + hstep, voffA);
            PG8_WAIT_V(8); PG8_WAIT_L(0); PG8_BAR; PG8_MMA(0, 0, At, B0); PG8_MMA(0, 1, At, B1); PG8_BAR; PG8_SCHED;
            PG8_LDA(At, 0, 1); PG8_STAGE(PG8_SB(0, 0), b2, voffB); PG8_STAGE(PG8_SB(0, 1), b2 + hstep, voffB); PG8_STAGE(PG8_SA(0, 0), a2, voffA);
            PG8_WAIT_V(8); PG8_WAIT_L(0); PG8_BAR; PG8_MMA(1, 0, At, B0); PG8_MMA(1, 1, At, B1); PG8_BAR; PG8_SCHED;
            PG8_LDB(B0, 1, 0); PG8_LDB(B1, 1, 1); PG8_SCHED; PG8_LDA(At, 1, 0); PG8_STAGE(PG8_SA(0, 1), a2 + hstep, voffA);
            PG8_WAIT_V(8); PG8_WAIT_L(0); PG8_BAR; PG8_MMA(0, 0, At, B0); PG8_MMA(0, 1, At, B1); PG8_BAR; PG8_SCHED;
            PG8_LDA(At, 1, 1); PG8_STAGE(PG8_SB(1, 0), b3, voffB); PG8_STAGE(PG8_SB(1, 1), b3 + hstep, voffB); PG8_STAGE(PG8_SA(1, 0), a3, voffA);
            PG8_WAIT_V(8); PG8_WAIT_L(0); PG8_BAR; PG8_MMA(1, 0, At, B0); PG8_MMA(1, 1, At, B1); PG8_BAR; PG8_SCHED;
            } else {
            PG8_LDB(B0, 0, 0); PG8_SCHED; PG8_LDA(At, 0, 0); PG8_STAGE(PG8_SA(1, 1), a1 + hstep, voffA);
            PG8_WAIT_L(8); PG8_BAR; PG8_WAIT_L(0); PG8_MMA(0, 0, At, B0); PG8_BAR; PG8_SCHED;
            PG8_LDB(B1, 0, 1); PG8_STAGE(PG8_SB(0, 0), b2, voffB);
            PG8_BAR; PG8_WAIT_L(0); PG8_MMA(0, 1, At, B1); PG8_BAR;
            PG8_LDA(At, 0, 1); PG8_STAGE(PG8_SA(0, 0), a2, voffA);
            PG8_BAR; PG8_WAIT_L(0); PG8_MMA(1, 0, At, B0); PG8_BAR; PG8_SCHED;
            PG8_STAGE(PG8_SB(0, 1), b2 + hstep, voffB);
            PG8_WAIT_V(6); PG8_BAR; PG8_MMA(1, 1, At, B1); PG8_BAR;
            PG8_LDB(B0, 1, 0); PG8_SCHED; PG8_LDA(At, 1, 0); PG8_STAGE(PG8_SA(0, 1), a2 + hstep, voffA);
            PG8_WAIT_L(8); PG8_BAR; PG8_WAIT_L(0); PG8_MMA(0, 0, At, B0); PG8_BAR; PG8_SCHED;
            PG8_LDB(B1, 1, 1); PG8_STAGE(PG8_SB(1, 0), b3, voffB);
            PG8_BAR; PG8_WAIT_L(0); PG8_MMA(0, 1, At, B1); PG8_BAR;
            PG8_LDA(At, 1, 1); PG8_STAGE(PG8_SA(1, 0), a3, voffA);
            PG8_BAR; PG8_WAIT_L(0); PG8_MMA(1, 0, At, B0); PG8_BAR; PG8_SCHED;
            PG8_STAGE(PG8_SB(1, 1), b3 + hstep, voffB);
            PG8_WAIT_V(6); PG8_BAR; PG8_MMA(1, 1, At, B1); PG8_BAR;
            }
        }
        if constexpr (ALIGN_EPI) { if (wr == 0) PG8_BAR; }
        if constexpr (!Epi::AFTER_DRAIN) { E(acc, cur, wr, wc, fr, fq); S.done(cur); }
        if (!has_next) break;
#pragma unroll
        for (int a = 0; a < 2; ++a)
#pragma unroll
            for (int b = 0; b < 2; ++b)
#pragma unroll
                for (int m = 0; m < 4; ++m)
#pragma unroll
                    for (int n = 0; n < 2; ++n) acc[a][b][m][n] = (f32x4){0.f, 0.f, 0.f, 0.f};
        cur = nxt; cA = nA; cB = nB; ++ui;
        if constexpr (ALIGN_EPI) { if (wr == 1) PG8_BAR; }
    }
    PG8_WAIT_V(0);
    if constexpr (!ALIGN_EPI) { if (wr == 0) PG8_BAR; }
    PG8_BAR;
    if constexpr (Epi::AFTER_DRAIN) { E.fused(acc, cur, wr, wc, fr, fq, lds, wid, lane); S.done(cur); }
#undef PG8_SA
#undef PG8_SB
#undef PG8_STAGE
#undef PG8_LDA
#undef PG8_LDB
#undef PG8_MMA
#undef PG8_WAIT_V
#undef PG8_WAIT_L
#undef PG8_BAR
#undef PG8_SCHED
}
}

constexpr int NTOK = 32768, DM = 1024, DFF = 2816, NGU = 2 * DFF, NPROJ = 3072, SEQ = 2048, NBATCH = 16;
constexpr float RMS_EPS = 1e-6f;
constexpr int NWAVES = 8, NTHREADS = 512;
constexpr int LDS_BYTES = 147456;
constexpr size_t MiB = 1u << 20;
constexpr size_t WS_W1GU = 0, WS_W1D = 12 * MiB, WS_W2GU = 18 * MiB, WS_W2D = 30 * MiB, WS_WIN = 36 * MiB, WS_WOUT = 42 * MiB;
constexpr size_t WS_XN = 48 * MiB;
constexpr size_t WS_H = 112 * MiB;
constexpr size_t WS_X1 = 308 * MiB;
constexpr size_t WS_HO = 436 * MiB;
constexpr size_t WS_CTL = 500 * MiB;
constexpr size_t WS_END = 501 * MiB;
constexpr int PROJ_PITCH = 3072 + 64;
constexpr size_t OUT_OP = 0;
constexpr size_t OUT_LSE = 96 * MiB;

#define LAS __attribute__((address_space(3)))
typedef unsigned short bf16;
typedef float f32x4 __attribute__((ext_vector_type(4)));
typedef float f32x16 __attribute__((ext_vector_type(16)));
typedef short bf16x8 __attribute__((ext_vector_type(8)));
typedef short s16x4 __attribute__((ext_vector_type(4)));
typedef unsigned u32x4 __attribute__((ext_vector_type(4)));
typedef unsigned u32x2 __attribute__((ext_vector_type(2)));

__device__ __forceinline__ unsigned cvtpk(float lo, float hi) { typedef float f2 __attribute__((ext_vector_type(2))); typedef __bf16 b2 __attribute__((ext_vector_type(2))); f2 v = {lo, hi}; b2 b = __builtin_convertvector(v, b2); return __builtin_bit_cast(unsigned, b); }
__device__ __forceinline__ float wave_sum(float v) {
#pragma unroll
    for (int o = 1; o < 64; o <<= 1) v += __shfl_xor(v, o);
    return v;
}

__device__ __forceinline__ void transpose_item(const float* W, const float* gk, int K, int N, bf16* WT, int rowbase, int k0, int n0, LAS float* scr, int lane) {
#pragma unroll 16
    for (int i = 0; i < 32; ++i) { const int kk = 2 * i + (lane >> 5); const float gg = gk ? gk[k0 + kk] : 1.0f; scr[kk * 33 + (lane & 31)] = W[(size_t)(k0 + kk) * N + n0 + (lane & 31)] * gg; }
    asm volatile("s_waitcnt lgkmcnt(0)" ::: "memory");
    const int c = lane & 7;
#pragma unroll
    for (int j = 0; j < 4; ++j) { const int n = (lane >> 3) + 8 * j; const LAS float* s = scr + (8 * c) * 33 + n;
        u32x4 o; o.x = cvtpk(s[0 * 33], s[1 * 33]); o.y = cvtpk(s[2 * 33], s[3 * 33]); o.z = cvtpk(s[4 * 33], s[5 * 33]); o.w = cvtpk(s[6 * 33], s[7 * 33]);
        *(u32x4*)(WT + (size_t)(rowbase + n) * K + k0 + 8 * c) = o; }
    asm volatile("s_waitcnt lgkmcnt(0)" ::: "memory");
}
__device__ __forceinline__ void transpose_matrix_item(const float* W, const float* gk, int K, int N, bf16* WT, int mode, int item, LAS float* scr, int lane) {
    const int nblk = N / 32, kb = item / nblk, nb = item % nblk, k0 = 64 * kb, n0 = 32 * nb;
    const int rowbase = (mode == 0) ? n0 : ((n0 >> 7) * 256 + (n0 & 127) + (mode == 2 ? 128 : 0));
    transpose_item(W, gk, K, N, WT, rowbase, k0, n0, scr, lane);
}
__device__ __forceinline__ void row_to_bf16_rstd(const float* xrow, bf16* orow, float* rstd, int lane) {
    const f32x4* xr = (const f32x4*)xrow + lane;
    f32x4 v[4]; float s = 0.f;
#pragma unroll
    for (int j = 0; j < 4; ++j) { v[j] = xr[64 * j]; s += (v[j].x * v[j].x + v[j].y * v[j].y) + (v[j].z * v[j].z + v[j].w * v[j].w); }
    const float r = 1.0f / sqrtf(wave_sum(s) * (1.0f / DM) + RMS_EPS);
    u32x2* o8 = (u32x2*)orow + lane;
#pragma unroll
    for (int j = 0; j < 4; ++j) { u32x2 w; w.x = cvtpk(v[j].x, v[j].y); w.y = cvtpk(v[j].z, v[j].w); o8[64 * j] = w; }
    if (lane == 0) *rstd = r;
}
__device__ __forceinline__ f32x4 bf4_to_f32(u32x2 w) { return (f32x4){__uint_as_float(w.x << 16), __uint_as_float(w.x & 0xffff0000u), __uint_as_float(w.y << 16), __uint_as_float(w.y & 0xffff0000u)}; }
template <bool XF32, bool OF32>
__device__ __forceinline__ void residual_row(const bf16* hrow, const void* xin, const float* gpost, float coef, void* xout, float* rstd, int lane) {
    const u32x2* hr = (const u32x2*)hrow + lane; const f32x4* gr = (const f32x4*)gpost + lane;
    f32x4 hv[4], xv[4]; float s = 0.f;
#pragma unroll
    for (int j = 0; j < 4; ++j) { hv[j] = bf4_to_f32(hr[64 * j]);
        if (XF32) xv[j] = ((const f32x4*)xin + lane)[64 * j]; else xv[j] = bf4_to_f32(((const u32x2*)xin + lane)[64 * j]);
        s += (hv[j].x * hv[j].x + hv[j].y * hv[j].y) + (hv[j].z * hv[j].z + hv[j].w * hv[j].w); }
    const float r = coef / sqrtf(wave_sum(s) * (1.0f / DM) + RMS_EPS);
    float s2 = 0.f;
#pragma unroll
    for (int j = 0; j < 4; ++j) { const f32x4 gg = gr[64 * j]; xv[j] = xv[j] + hv[j] * gg * r; s2 += (xv[j].x * xv[j].x + xv[j].y * xv[j].y) + (xv[j].z * xv[j].z + xv[j].w * xv[j].w); }
    if (OF32) {
        f32x4* xo = (f32x4*)xout + lane;
#pragma unroll
        for (int j = 0; j < 4; ++j) xo[64 * j] = xv[j];
    } else {
        u32x2* o8 = (u32x2*)xout + lane;
#pragma unroll
        for (int j = 0; j < 4; ++j) { u32x2 w; w.x = cvtpk(xv[j].x, xv[j].y); w.y = cvtpk(xv[j].z, xv[j].w); o8[64 * j] = w; }
        const float r2 = 1.0f / sqrtf(wave_sum(s2) * (1.0f / DM) + RMS_EPS);
        if (lane == 0) *rstd = r2;
    }
}

namespace att {
constexpr int PITCH = PROJ_PITCH;
constexpr int KSTR = 272, VSTR = 320;
constexpr int KT = 64 * KSTR, VT = 64 * VSTR, STAGE = KT + VT;
constexpr int XCH_OFF = 2 * STAGE;
static_assert(XCH_OFF + 65536 <= LDS_BYTES, "attention LDS map");
#define MFMA32(a, b, c) __builtin_amdgcn_mfma_f32_32x32x16_bf16((a), (b), (c), 0, 0, 0)

struct Unit {
    const bf16* q; const bf16* k; const bf16* v;
    int dil, res, q0, t_lo, t_hi;
    float slope2d;
};

template <bool DIFF>
__device__ __forceinline__ void sub_block(const LAS unsigned char* kp, const LAS unsigned char* vp, int dq, float sl, const bf16x8 (&qf)[4],
                                          f32x16 (&o)[DIFF ? 4 : 2], float& m, float& l, bool& started, int r32, int h) {
    constexpr int NDV = DIFF ? 4 : 2;
    constexpr float THR = 6.0f;
    if (dq > 31) return;
    if (!DIFF && (-dq - 31 > 128)) return;
    f32x16 s; const float base = sl * (float)(dq + 8 * h - r32) - m;
#pragma unroll
    for (int i = 0; i < 16; ++i) s[i] = sl * (float)((i & 7) + 16 * (i >> 3)) + base;
    bf16x8 kf[4];
#pragma unroll
    for (int kk = 0; kk < 4; ++kk) kf[kk] = *(const LAS bf16x8*)(kp + kk * 32);
    __builtin_amdgcn_sched_barrier(0);
#pragma unroll
    for (int kk = 0; kk < 4; ++kk) s = MFMA32(kf[kk], qf[kk], s);
    const bool need_mask = (dq + 31 > 0) || (!DIFF && (31 - dq > 128));
    if (need_mask) {
#pragma unroll
        for (int i = 0; i < 16; ++i) { const int rel = dq + ((i & 7) + 8 * h + 16 * (i >> 3)) - r32;
            const bool valid = (rel <= 0) && (DIFF || rel >= -128); s[i] = valid ? s[i] : -INFINITY; }
    }
    float mx = fmaxf(fmaxf(s[0], s[1]), s[2]);
#pragma unroll
    for (int i = 3; i < 15; i += 2) mx = fmaxf(fmaxf(mx, s[i]), s[i + 1]);
    mx = fmaxf(mx, s[15]);
    mx = fmaxf(mx, __shfl_xor(mx, 32));
    if (!started || __any(mx > THR)) {
        const float delta = started ? fmaxf(mx, 0.f) : mx;
#pragma unroll
        for (int i = 0; i < 16; ++i) s[i] -= delta;
        m += delta;
        if (started) { const float alpha = __builtin_amdgcn_exp2f(-delta); l *= alpha;
#pragma unroll
            for (int d = 0; d < NDV; ++d)
#pragma unroll
                for (int i = 0; i < 16; ++i) o[d][i] *= alpha; }
        started = true;
    }
    float ps = 0.f;
#pragma unroll
    for (int i = 0; i < 16; ++i) { s[i] = __builtin_amdgcn_exp2f(s[i]); ps += s[i]; }
    l += ps;
    u32x4 p0, p1;
    p0.x = cvtpk(s[0], s[1]); p0.y = cvtpk(s[2], s[3]); p0.z = cvtpk(s[4], s[5]); p0.w = cvtpk(s[6], s[7]);
    p1.x = cvtpk(s[8], s[9]); p1.y = cvtpk(s[10], s[11]); p1.z = cvtpk(s[12], s[13]); p1.w = cvtpk(s[14], s[15]);
    const bf16x8 pf0 = __builtin_bit_cast(bf16x8, p0), pf1 = __builtin_bit_cast(bf16x8, p1);
    typedef short v4i16_t __attribute__((ext_vector_type(4)));
#pragma unroll
    for (int d = 0; d < NDV; ++d) {
#pragma unroll
        for (int ss = 0; ss < 2; ++ss) {
            const LAS unsigned char* a = vp + ss * 16 * VSTR + d * 64;
            const s16x4 lo = __builtin_bit_cast(s16x4, __builtin_amdgcn_ds_read_tr16_b64_v4i16((LAS v4i16_t*)(a)));
            const s16x4 hi = __builtin_bit_cast(s16x4, __builtin_amdgcn_ds_read_tr16_b64_v4i16((LAS v4i16_t*)(a + 4 * VSTR)));
            const bf16x8 vf = __builtin_shufflevector(lo, hi, 0, 1, 2, 3, 4, 5, 6, 7);
            o[d] = MFMA32(vf, ss == 0 ? pf0 : pf1, o[d]);
        }
    }
}

__device__ __forceinline__ void tile_full(const LAS unsigned char* kp, const LAS unsigned char* vp, int dq, float sl, const bf16x8 (&qf)[4],
                                          f32x16 (&o)[4], float& m, float& l, int r32, int h) {
    constexpr float THR = 6.0f;
    typedef short v4i16_t __attribute__((ext_vector_type(4)));
    bf16x8 k0[4];
#pragma unroll
    for (int kk = 0; kk < 4; ++kk) k0[kk] = *(const LAS bf16x8*)(kp + kk * 32);
    f32x16 s0, s1; const float base0 = sl * (float)(dq + 8 * h - r32) - m, base1 = base0 + sl * 32.0f;
#pragma unroll
    for (int i = 0; i < 16; ++i) { const float ci = sl * (float)((i & 7) + 16 * (i >> 3)); s0[i] = ci + base0; s1[i] = ci + base1; }
    __builtin_amdgcn_sched_barrier(0);
    bf16x8 k1[4];
#pragma unroll
    for (int kk = 0; kk < 4; ++kk) { k1[kk] = *(const LAS bf16x8*)(kp + 32 * KSTR + kk * 32); s0 = MFMA32(k0[kk], qf[kk], s0); }
#pragma unroll
    for (int kk = 0; kk < 4; ++kk) s1 = MFMA32(k1[kk], qf[kk], s1);
    float mx = fmaxf(fmaxf(s0[0], s0[1]), s1[0]);
    mx = fmaxf(fmaxf(mx, s1[1]), s0[2]);
#pragma unroll
    for (int i = 3; i < 15; i += 2) { mx = fmaxf(fmaxf(mx, s0[i]), s0[i + 1]); mx = fmaxf(fmaxf(mx, s1[i - 1]), s1[i]); }
    mx = fmaxf(fmaxf(mx, s0[15]), fmaxf(s1[14], s1[15]));
    mx = fmaxf(mx, __shfl_xor(mx, 32));
    if (!__any(mx > -134.0f)) return;
    if (__any(mx > THR)) {
        const float delta = fmaxf(mx, 0.f);
#pragma unroll
        for (int i = 0; i < 16; ++i) { s0[i] -= delta; s1[i] -= delta; }
        m += delta;
        const float alpha = __builtin_amdgcn_exp2f(-delta); l *= alpha;
#pragma unroll
        for (int d = 0; d < 4; ++d)
#pragma unroll
            for (int i = 0; i < 16; ++i) o[d][i] *= alpha;
    }
    float ps0 = 0.f, ps1 = 0.f;
#pragma unroll
    for (int i = 0; i < 16; ++i) { s0[i] = __builtin_amdgcn_exp2f(s0[i]); ps0 += s0[i]; }
#pragma unroll
    for (int i = 0; i < 16; ++i) { s1[i] = __builtin_amdgcn_exp2f(s1[i]); ps1 += s1[i]; }
    l += ps0 + ps1;
    u32x4 pw[4];
    pw[0].x = cvtpk(s0[0], s0[1]); pw[0].y = cvtpk(s0[2], s0[3]); pw[0].z = cvtpk(s0[4], s0[5]); pw[0].w = cvtpk(s0[6], s0[7]);
    pw[1].x = cvtpk(s0[8], s0[9]); pw[1].y = cvtpk(s0[10], s0[11]); pw[1].z = cvtpk(s0[12], s0[13]); pw[1].w = cvtpk(s0[14], s0[15]);
    pw[2].x = cvtpk(s1[0], s1[1]); pw[2].y = cvtpk(s1[2], s1[3]); pw[2].z = cvtpk(s1[4], s1[5]); pw[2].w = cvtpk(s1[6], s1[7]);
    pw[3].x = cvtpk(s1[8], s1[9]); pw[3].y = cvtpk(s1[10], s1[11]); pw[3].z = cvtpk(s1[12], s1[13]); pw[3].w = cvtpk(s1[14], s1[15]);
#pragma unroll
    for (int d = 0; d < 4; ++d) {
#pragma unroll
        for (int ks = 0; ks < 4; ++ks) {
            const LAS unsigned char* a = vp + ks * 16 * VSTR + d * 64;
            const s16x4 lo = __builtin_bit_cast(s16x4, __builtin_amdgcn_ds_read_tr16_b64_v4i16((LAS v4i16_t*)(a)));
            const s16x4 hi = __builtin_bit_cast(s16x4, __builtin_amdgcn_ds_read_tr16_b64_v4i16((LAS v4i16_t*)(a + 4 * VSTR)));
            const bf16x8 vf = __builtin_shufflevector(lo, hi, 0, 1, 2, 3, 4, 5, 6, 7);
            o[d] = MFMA32(vf, __builtin_bit_cast(bf16x8, pw[ks]), o[d]);
        }
        if (d & 1) __builtin_amdgcn_sched_barrier(0);
    }
}

template <bool DIFF>
__device__ __forceinline__ void attn_unit(LAS unsigned char* lds, const Unit& U, int tokbase, bf16* outp, float* lsep, float lam, const float* gsub, float post, int flags) {
    constexpr int NDV = DIFF ? 4 : 2;
    int tid = threadIdx.x; asm volatile("" : "+v"(tid));
    const int lane = tid & 63, wid = __builtin_amdgcn_readfirstlane(tid >> 6), rg = wid & 3, c = wid >> 2, r32 = lane & 31, h = lane >> 5;
    const int qidx = U.q0 + 32 * rg;
    const bf16* qrow = U.q + (size_t)(U.res + (qidx + r32) * U.dil) * PITCH + c * 64 + 8 * h;
    bf16x8 qf[4];
#pragma unroll
    for (int kk = 0; kk < 4; ++kk) qf[kk] = *(const bf16x8*)(qrow + 16 * kk);
    f32x16 o[NDV];
#pragma unroll
    for (int d = 0; d < NDV; ++d)
#pragma unroll
        for (int i = 0; i < 16; ++i) o[d][i] = 0.f;
    float m = 0.f, l = 0.f; bool started = false;
    const float sl = U.slope2d;
    const int srow0 = tid >> 4, sch = tid & 15;
    const size_t tstep = (size_t)64 * U.dil * PITCH;
    const bf16* gk0 = U.k + (size_t)(U.res + (64 * U.t_lo + srow0) * U.dil) * PITCH + sch * 8;
    const bf16* gv0 = U.v + (size_t)(U.res + (64 * U.t_lo + srow0) * U.dil) * PITCH + sch * 8;
    const size_t rstep32 = (size_t)32 * U.dil * PITCH;
    const int lk0 = srow0 * KSTR + sch * 16, lv0 = KT + srow0 * VSTR + sch * 16;
    const int pi = (r32 & 0x13) | (((r32 >> 3) & 1) << 2) | (((r32 >> 2) & 1) << 3);
    const int koffb = pi * KSTR + (c * 64 + 8 * h) * 2;
    const int i16 = lane & 15, q4 = i16 >> 2, p4 = i16 & 3, blk = (lane >> 4) & 1;
    const int voffb = KT + (8 * h + q4) * VSTR + ((DIFF ? 0 : c * 64) + 16 * blk + 4 * p4) * 2;

    __syncthreads();
    const int nt = U.t_hi - U.t_lo;
    u32x4 rk0, rk1, rv0, rv1;
    { const bf16* gk = gk0 + (size_t)(nt - 1) * tstep; const bf16* gv = gv0 + (size_t)(nt - 1) * tstep;
      rk0 = *(const u32x4*)gk; rk1 = *(const u32x4*)(gk + rstep32); rv0 = *(const u32x4*)gv; rv1 = *(const u32x4*)(gv + rstep32); }
    *(LAS u32x4*)(lds + lk0) = rk0; *(LAS u32x4*)(lds + lk0 + 32 * KSTR) = rk1; *(LAS u32x4*)(lds + lv0) = rv0; *(LAS u32x4*)(lds + lv0 + 32 * VSTR) = rv1;
    __syncthreads();
    for (int j = 0; j < nt; ++j) {
        const int tt = nt - 1 - j;
        const int cur = (j & 1) * STAGE; const bool more = (j + 1 < nt);
        if (more && !(flags & 4)) { const bf16* gk = gk0 + (size_t)(tt - 1) * tstep; const bf16* gv = gv0 + (size_t)(tt - 1) * tstep;
            rk0 = *(const u32x4*)gk; rk1 = *(const u32x4*)(gk + rstep32); rv0 = *(const u32x4*)gv; rv1 = *(const u32x4*)(gv + rstep32); }
        const int dq = 64 * (U.t_lo + tt) - qidx;
        if (flags & 8) {} else if (DIFF && j >= 2) {
            if constexpr (DIFF) tile_full(lds + cur + koffb, lds + cur + voffb, dq, sl, qf, o, m, l, r32, h);
        } else {
            sub_block<DIFF>(lds + cur + koffb + 32 * KSTR, lds + cur + voffb + 32 * VSTR, dq + 32, sl, qf, o, m, l, started, r32, h);
            sub_block<DIFF>(lds + cur + koffb, lds + cur + voffb, dq, sl, qf, o, m, l, started, r32, h);
        }
        if (more && !(flags & 4)) { const int nx = STAGE - cur;
            *(LAS u32x4*)(lds + nx + lk0) = rk0; *(LAS u32x4*)(lds + nx + lk0 + 32 * KSTR) = rk1; *(LAS u32x4*)(lds + nx + lv0) = rv0; *(LAS u32x4*)(lds + nx + lv0 + 32 * VSTR) = rv1; }
        __syncthreads();
    }
    const float lt = l + __shfl_xor(l, 32);
    const float inv = 1.0f / lt;
    const int tok = tokbase + U.res + (qidx + r32) * U.dil;
    if (DIFF) {
        LAS float* xch = (LAS float*)(lds + XCH_OFF) + rg * 4096 + lane;
        if (c == 1) { const float f = inv * lam;
#pragma unroll
            for (int d = 0; d < NDV; ++d)
#pragma unroll
                for (int i = 0; i < 16; ++i) xch[(d * 16 + i) * 64] = o[d][i] * f; }
        __syncthreads();
        if (c == 0) {
            float ss = 0.f;
#pragma unroll
            for (int d = 0; d < NDV; ++d)
#pragma unroll
                for (int i = 0; i < 16; ++i) { const float v = o[d][i] * inv - xch[(d * 16 + i) * 64]; o[d][i] = v; ss += v * v; }
            ss += __shfl_xor(ss, 32);
            const float r = post / sqrtf(ss * (1.0f / 128.0f) + RMS_EPS);
            bf16* orow = outp + (size_t)tok * DM;
#pragma unroll
            for (int d = 0; d < NDV; ++d)
#pragma unroll
                for (int g = 0; g < 4; ++g) { const int dv = 32 * d + 8 * g + 4 * h; const f32x4 gg = *(const f32x4*)(gsub + dv);
                    u32x2 w; w.x = cvtpk(o[d][4 * g] * r * gg.x, o[d][4 * g + 1] * r * gg.y); w.y = cvtpk(o[d][4 * g + 2] * r * gg.z, o[d][4 * g + 3] * r * gg.w);
                    *(u32x2*)(orow + dv) = w; }
        }
    } else {
        LAS unsigned char* st = lds + wid * 4608;
#pragma unroll
        for (int d = 0; d < NDV; ++d)
#pragma unroll
            for (int g = 0; g < 4; ++g) { const int dv = 32 * d + 8 * g + 4 * h;
                u32x2 w; w.x = cvtpk(o[d][4 * g] * inv, o[d][4 * g + 1] * inv); w.y = cvtpk(o[d][4 * g + 2] * inv, o[d][4 * g + 3] * inv);
                *(LAS u32x2*)(st + r32 * 144 + dv * 2) = w; }
#pragma unroll
        for (int i = 0; i < 4; ++i) { const int row = i * 8 + (lane >> 3), ch = lane & 7;
            const u32x4 v = *(const LAS u32x4*)(st + row * 144 + ch * 16);
            *(u32x4*)(outp + (size_t)(tokbase + U.res + (qidx + row) * U.dil) * 512 + c * 64 + ch * 8) = v; }
        if (h == 0) lsep[(size_t)tok * 8 + c] = m + __builtin_log2f(lt);
    }
}
}

#define XB_TMO      128
#define XB_XCNT(j)  (256  + 64 * (j))
#define XB_XSUB(j)  (1280 + 64 * (j))
#define XB_XGEN(j)  (2304 + 64 * (j))
#define XB_TOP      3328
#define XB_TOPGEN   3392
#define XCD_BAR_WORDS 3456
#define XB_SPIN_CAP (1u << 18)

__device__ __forceinline__ unsigned xb_ld(unsigned* p)              { return __hip_atomic_load(p, __ATOMIC_RELAXED, __HIP_MEMORY_SCOPE_AGENT); }
__device__ __forceinline__ unsigned xb_add(unsigned* p, unsigned v) { return __hip_atomic_fetch_add(p, v, __ATOMIC_RELAXED, __HIP_MEMORY_SCOPE_AGENT); }
__device__ __forceinline__ unsigned xb_xcc_id() { return (unsigned)__builtin_amdgcn_s_getreg((3 << 11) | 20) & 0xFu; }
#define XB_SPIN(cond, bar) do { unsigned _sp = 0; while (cond) { __builtin_amdgcn_s_sleep(1); \
    if ((++_sp & 255u) == 0u) { if (xb_ld(&(bar)[XB_TMO])) break; if (_sp > XB_SPIN_CAP) { atomicAdd(&(bar)[XB_TMO], 1u); break; } } } } while (0)

struct XcdBarrier {
    unsigned* bar; unsigned x;
    volatile LAS unsigned* st;
};

__device__ __forceinline__ XcdBarrier xcd_barrier_post(unsigned* bar, volatile LAS unsigned* st) {
    XcdBarrier b; b.bar = bar; b.x = xb_xcc_id(); b.st = st;
    if (threadIdx.x == 0) (void)xb_add(&bar[XB_XCNT(b.x)], 1u);
    return b;
}
__device__ __forceinline__ void xcd_barrier_complete(unsigned* bar, unsigned x, unsigned& nloc, unsigned& nx) {
    const unsigned G = gridDim.x * gridDim.y * gridDim.z;
    unsigned sum, cnt, mine, sp = 0u;
    for (;;) {
        sum = 0u; cnt = 0u; mine = 0u;
#pragma unroll
        for (unsigned j = 0; j < 16; ++j) { const unsigned c = xb_ld(&bar[XB_XCNT(j)]); sum += c; cnt += (c > 0u) ? 1u : 0u; mine = (j == x) ? c : mine; }
        if (sum == G) break;
        __builtin_amdgcn_s_sleep(1);
        if ((++sp & 255u) == 0u) { if (xb_ld(&bar[XB_TMO])) break; if (sp > XB_SPIN_CAP) { atomicAdd(&bar[XB_TMO], 1u); break; } }
    }
    nloc = mine > 0u ? mine : 1u; nx = cnt > 0u ? cnt : 1u;
}

__device__ __forceinline__ void xcd_barrier(const XcdBarrier& b) {
    asm volatile("s_waitcnt vmcnt(0)" ::: "memory");
    __syncthreads();
    if (threadIdx.x == 0) {
        unsigned* bar = b.bar;
        __builtin_amdgcn_s_waitcnt(0);
        unsigned nloc = b.st[0], nx = b.st[1];
        if (nloc == 0u) { xcd_barrier_complete(bar, b.x, nloc, nx); b.st[0] = nloc; b.st[1] = nx; }
        const unsigned old = xb_add(&bar[XB_XSUB(b.x)], 1u);
        const unsigned gen = old / nloc;
        if (old + 1u == (gen + 1u) * nloc) {
            __builtin_amdgcn_fence(__ATOMIC_RELEASE, "agent");
            asm volatile("s_waitcnt vmcnt(0)" ::: "memory");
            const unsigned og = xb_add(&bar[XB_TOP], 1u);
            const unsigned tg = og / nx;
            if (og + 1u == (tg + 1u) * nx) xb_add(&bar[XB_TOPGEN], 1u);
            else XB_SPIN(xb_ld(&bar[XB_TOPGEN]) == tg, bar);
            __builtin_amdgcn_fence(__ATOMIC_ACQUIRE, "agent");
            xb_add(&bar[XB_XGEN(b.x)], 1u);
            asm volatile("s_waitcnt vmcnt(0)" ::: "memory");
        } else {
            XB_SPIN(xb_ld(&bar[XB_XGEN(b.x)]) == gen, bar);
            __builtin_amdgcn_fence(__ATOMIC_ACQUIRE, "agent");
            asm volatile("s_waitcnt vmcnt(0)" ::: "memory");
        }
    }
    __syncthreads();
}


struct Args { const float* in[20]; float* out; unsigned char* ws; int ph_lo, ph_hi, att_mask, pad; };
constexpr int N_PHASES = 12;

__global__ void __launch_bounds__(NTHREADS, 2) mega_fwd(Args args) {
    extern __shared__ __attribute__((aligned(16))) unsigned char lds_raw[];
    LAS unsigned char* lds = (LAS unsigned char*)lds_raw;
    cg::grid_group grid = cg::this_grid();
    const int G = gridDim.x, bx = blockIdx.x, NGW = G * NWAVES;
#define PHASE_IDS int tid = threadIdx.x; asm volatile("" : "+v"(tid)); const int lane = tid & 63, wave = __builtin_amdgcn_readfirstlane(tid >> 6), gw = bx * NWAVES + wave; (void)lane; (void)gw;
    unsigned char* ws = args.ws;
    const float* x = args.in[0];
    bf16* W1GU = (bf16*)(ws + WS_W1GU); bf16* W1D = (bf16*)(ws + WS_W1D); bf16* W2GU = (bf16*)(ws + WS_W2GU); bf16* W2D = (bf16*)(ws + WS_W2D);
    bf16* WIN = (bf16*)(ws + WS_WIN); bf16* WOUT = (bf16*)(ws + WS_WOUT);
    bf16* XN = (bf16*)(ws + WS_XN); bf16* HB = (bf16*)(ws + WS_H); bf16* MIXB = (bf16*)(ws + WS_X1); float* RSTD = (float*)(ws + WS_X1 + 64 * MiB);
    bf16* HO = (bf16*)(ws + WS_HO);
    unsigned* CTL = (unsigned*)(ws + WS_CTL);
    volatile LAS unsigned* MISC = (volatile LAS unsigned*)(lds + LDS_BYTES - 64);
    if (threadIdx.x < 16) MISC[threadIdx.x] = 0u;
    __syncthreads();
    XcdBarrier bar; bar.bar = CTL; bar.x = 0; bar.st = MISC;
    bf16* OP = (bf16*)((unsigned char*)args.out + OUT_OP); float* LSE = (float*)((unsigned char*)args.out + OUT_LSE);
    const int lo = args.ph_lo, hi = args.ph_hi;
#define IN(k) (lo <= (k) && (k) < hi)
#define SEAM(k) do { if (IN(k) && IN((k) + 1)) { if ((k) == 0) { grid.sync(); bar = xcd_barrier_post(CTL, MISC); } else xcd_barrier(bar); } } while (0)

    if (IN(0)) {
        PHASE_IDS
        if (bx == 0) for (int i = tid; i < XCD_BAR_WORDS; i += NTHREADS) CTL[i] = 0u;
        LAS float* scr = (LAS float*)(lds + wave * 16384);
        constexpr int I_G = (DM / 64) * (DFF / 32), I_D = (DFF / 64) * (DM / 32), I_IN = (DM / 64) * (NPROJ / 32), I_OUT = (DM / 64) * (DM / 32);
        constexpr int NITEMS = 6 * I_G + I_IN + I_OUT;
        static_assert(I_G == I_D, "item counts");
        for (int it = gw; it < NITEMS; it += NGW) {
            int r = it;
            if (r < I_G) { transpose_matrix_item(args.in[2], args.in[1], DM, DFF, W1GU, 1, r, scr, lane); continue; } r -= I_G;
            if (r < I_G) { transpose_matrix_item(args.in[3], args.in[1], DM, DFF, W1GU, 2, r, scr, lane); continue; } r -= I_G;
            if (r < I_D) { transpose_matrix_item(args.in[4], nullptr, DFF, DM, W1D, 0, r, scr, lane); continue; } r -= I_D;
            if (r < I_G) { transpose_matrix_item(args.in[16], args.in[15], DM, DFF, W2GU, 1, r, scr, lane); continue; } r -= I_G;
            if (r < I_G) { transpose_matrix_item(args.in[17], args.in[15], DM, DFF, W2GU, 2, r, scr, lane); continue; } r -= I_G;
            if (r < I_D) { transpose_matrix_item(args.in[18], nullptr, DFF, DM, W2D, 0, r, scr, lane); continue; } r -= I_D;
            if (r < I_IN) { transpose_matrix_item(args.in[7], args.in[6], DM, NPROJ, WIN, 0, r, scr, lane); continue; } r -= I_IN;
            transpose_matrix_item(args.in[13], nullptr, DM, DM, WOUT, 0, r, scr, lane);
        }
        for (int mrow = gw; mrow < NTOK; mrow += NGW) row_to_bf16_rstd(x + (size_t)mrow * DM, XN + (size_t)mrow * DM, RSTD + mrow, lane);
        __syncthreads();
    }
    SEAM(0);
    if (IN(1)) { pg8::Gemm g{XN, W1GU, NTOK, NGU, DM}; pg8::StaticOrder S; S.init(NTOK, NGU, G, bx); pg8::EpiSwiglu E{HB, DFF, RSTD};
        pg8::gemm_phase<pg8::EpiSwiglu, pg8::StaticOrder, true, true>(lds, g, S, E); }
    SEAM(1);
    if (IN(2)) { pg8::Gemm g{HB, W1D, NTOK, DM, DFF}; pg8::StaticOrder S; S.init(NTOK, DM, G, bx); pg8::EpiBf16<0> E{HO, DM, nullptr, 0, 0, 1.f};
        pg8::gemm_phase<pg8::EpiBf16<0>, pg8::StaticOrder, true, true>(lds, g, S, E); }
    SEAM(2);
    if (IN(3)) { PHASE_IDS for (int mrow = gw; mrow < NTOK; mrow += NGW) { const size_t o = (size_t)mrow * DM; residual_row<true, false>(HO + o, x + o, args.in[5], 0.5f, XN + o, RSTD + mrow, lane); } }
    SEAM(3);
    if (IN(4)) { pg8::Gemm g{XN, WIN, NTOK, NPROJ, DM}; pg8::StaticOrder S; S.init(NTOK, NPROJ, G, bx); pg8::EpiProj E{HB, PROJ_PITCH, 0.125f * 1.4426950408889634f, RSTD};
        pg8::gemm_phase<pg8::EpiProj, pg8::StaticOrder, true, true>(lds, g, S, E); }
    SEAM(4);
    if (IN(5)) {
        PHASE_IDS
        bf16* MIX = MIXB;
        float lam;
        { const float a = (lane < 64) ? args.in[8][lane] * args.in[9][lane] : 0.f, b = args.in[10][lane] * args.in[11][lane];
          lam = __expf(wave_sum(a)) - __expf(wave_sum(b)) + 0.2f; }
        const float LOG2E = 1.4426950408889634f;
        const int xcd = bx & 7, wl = bx >> 3, nwx = (G - xcd + 7) >> 3;
        if (args.att_mask & 1) for (int v = wl, jr = 0; v < 128; v += nwx, ++jr) {
            const int bh = 8 * xcd + 4 * ((v >> 4) & 1) + (v >> 5), i16 = v & 15, b = bh >> 2, hd = bh & 3;
            const float slope = exp2f(-8.0f * (float)(3 * hd + 1) / 12.0f);
            {
                const int qb = (jr & 1) ? 15 - i16 : i16;
                att::Unit U; const bf16* base = HB + (size_t)b * SEQ * PROJ_PITCH;
                U.q = base + hd * 128; U.k = base + 512 + hd * 128; U.v = base + 1024 + hd * 128;
                U.dil = 1; U.res = 0; U.q0 = 128 * qb; U.t_lo = 0; U.t_hi = 2 * qb + 2; U.slope2d = slope * LOG2E;
                att::attn_unit<true>(lds, U, b * SEQ, MIX + hd * 128, nullptr, lam, args.in[12], 0.8f, args.att_mask);
            }
        }
        if (args.att_mask & 2) for (int v = wl; v < 384; v += nwx) {
            const int k = v % 48, bh = 8 * xcd + v / 48, b = bh >> 2, hp = bh & 3;
            int pat, res, n, dil;
            if (k < 16) { pat = 0; res = 0; n = k; dil = 1; } else if (k < 32) { pat = 1; res = (k - 16) & 3; n = (k - 16) >> 2; dil = 4; } else { pat = 2; res = k - 32; n = 0; dil = 16; }
            const int cw = wave >> 2, head = 2 * hp + cw, aidx = head + 1 + (head >> 1);
            const float slope = exp2f(-8.0f * (float)(aidx + 1) / 12.0f);
            att::Unit U; const bf16* base = HB + (size_t)b * SEQ * PROJ_PITCH;
            U.q = base + 1536 + hp * 128; U.k = base + 2048 + hp * 128; U.v = base + 2560 + hp * 128;
            U.dil = dil; U.res = res; U.q0 = 128 * n; U.t_lo = (n == 0) ? 0 : 2 * n - 2; U.t_hi = 2 * n + 2; U.slope2d = slope * LOG2E * (float)dil;
            att::attn_unit<false>(lds, U, b * SEQ, OP + (size_t)pat * NTOK * 512 + hp * 128, LSE + (size_t)pat * NTOK * 8 + hp * 2, 0.f, nullptr, 0.f, args.att_mask);
        }
    }
    SEAM(5);
    if (IN(6)) {
        PHASE_IDS
        bf16* MIX = MIXB;
        const int nth = G * NTHREADS;
        for (int it = bx * NTHREADS + tid; it < NTOK * 64; it += nth) {
            const int tok = it >> 6, hc = it & 63, head = hc >> 3;
            const float l0 = LSE[(size_t)tok * 8 + head], l1 = LSE[(size_t)NTOK * 8 + (size_t)tok * 8 + head], l2 = LSE[(size_t)2 * NTOK * 8 + (size_t)tok * 8 + head];
            const float mx = fmaxf(l0, fmaxf(l1, l2));
            float w0 = __builtin_amdgcn_exp2f(l0 - mx), w1 = __builtin_amdgcn_exp2f(l1 - mx), w2 = __builtin_amdgcn_exp2f(l2 - mx);
            const float iw = 1.0f / (w0 + w1 + w2); w0 *= iw; w1 *= iw; w2 *= iw;
            const u32x4 a = *(const u32x4*)(OP + (size_t)tok * 512 + hc * 8), bq = *(const u32x4*)(OP + (size_t)NTOK * 512 + (size_t)tok * 512 + hc * 8), cq = *(const u32x4*)(OP + (size_t)2 * NTOK * 512 + (size_t)tok * 512 + hc * 8);
            u32x4 r;
#pragma unroll
            for (int j = 0; j < 4; ++j) {
                const float alo = __uint_as_float(a[j] << 16), ahi = __uint_as_float(a[j] & 0xffff0000u), blo = __uint_as_float(bq[j] << 16), bhi = __uint_as_float(bq[j] & 0xffff0000u),
                            clo = __uint_as_float(cq[j] << 16), chi = __uint_as_float(cq[j] & 0xffff0000u);
                r[j] = cvtpk(w0 * alo + w1 * blo + w2 * clo, w0 * ahi + w1 * bhi + w2 * chi);
            }
            *(u32x4*)(MIX + (size_t)tok * DM + 512 + hc * 8) = r;
        }
    }
    SEAM(6);
    if (IN(7)) { pg8::Gemm g{MIXB, WOUT, NTOK, DM, DM}; pg8::StaticOrder S; S.init(NTOK, DM, G, bx); pg8::EpiBf16<0> E{HO, DM, nullptr, 0, 0, 1.f};
        pg8::gemm_phase<pg8::EpiBf16<0>, pg8::StaticOrder, true, true>(lds, g, S, E); }
    SEAM(7);
    if (IN(8)) { PHASE_IDS for (int mrow = gw; mrow < NTOK; mrow += NGW) { const size_t o = (size_t)mrow * DM; residual_row<false, false>(HO + o, XN + o, args.in[14], 1.0f, XN + o, RSTD + mrow, lane); } }
    SEAM(8);
    if (IN(9)) { pg8::Gemm g{XN, W2GU, NTOK, NGU, DM}; pg8::StaticOrder S; S.init(NTOK, NGU, G, bx); pg8::EpiSwiglu E{HB, DFF, RSTD};
        pg8::gemm_phase<pg8::EpiSwiglu, pg8::StaticOrder, true, true>(lds, g, S, E); }
    SEAM(9);
    if (IN(10)) { pg8::Gemm g{HB, W2D, NTOK, DM, DFF}; pg8::StaticOrder S; S.init(NTOK, DM, G, bx); pg8::EpiBf16<0> E{HO, DM, nullptr, 0, 0, 1.f};
        pg8::gemm_phase<pg8::EpiBf16<0>, pg8::StaticOrder, true, true>(lds, g, S, E); }
    SEAM(10);
    if (IN(11)) { PHASE_IDS for (int mrow = gw; mrow < NTOK; mrow += NGW) { const size_t o = (size_t)mrow * DM; residual_row<false, true>(HO + o, XN + o, args.in[19], 0.5f, args.out + o, nullptr, lane); } }
#undef IN
#undef SEAM
}

#ifndef MK_DUP_ATT
#define MK_DUP_ATT 3
#endif
#ifndef MK_DUP_A
#define MK_DUP_A -1
#endif
#ifndef MK_DUP_B
#define MK_DUP_B -1
#endif
#ifndef MK_PER_PHASE
#define MK_PER_PHASE 0
#endif
extern "C" void kernel_launch(void* const* d_in, const int* in_sizes, int n_in, void* d_out, int out_size, void* d_ws, size_t ws_size, hipStream_t stream) {
    static int grid = 0;
    if (grid == 0) {
        if (n_in != 20 || in_sizes[0] != NTOK * DM || out_size != NTOK * DM || ws_size < WS_END) {
            fprintf(stderr, "kernel_launch: unexpected problem (n_in %d, in0 %d, out %d, ws %zu); nothing launched\n", n_in, n_in > 0 ? in_sizes[0] : -1, out_size, ws_size); grid = -1; return; }
        int dev = 0, cus = 0, per_cu = 0;
        if (hipGetDevice(&dev) != hipSuccess || hipDeviceGetAttribute(&cus, hipDeviceAttributeMultiprocessorCount, dev) != hipSuccess) { fprintf(stderr, "kernel_launch: device query failed\n"); grid = -1; return; }
        if (hipFuncSetAttribute((const void*)mega_fwd, hipFuncAttributeMaxDynamicSharedMemorySize, LDS_BYTES) != hipSuccess) { fprintf(stderr, "kernel_launch: hipFuncSetAttribute failed\n"); grid = -1; return; }
        if (hipOccupancyMaxActiveBlocksPerMultiprocessor(&per_cu, (const void*)mega_fwd, NTHREADS, LDS_BYTES) != hipSuccess || per_cu < 1) { fprintf(stderr, "kernel_launch: occupancy query says %d\n", per_cu); per_cu = 1; }
        (void)hipGetLastError();
        grid = cus;
    }
    if (grid < 0) return;
    Args a{};
    for (int i = 0; i < 20; ++i) a.in[i] = (const float*)d_in[i];
    a.out = (float*)d_out; a.ws = (unsigned char*)d_ws; a.att_mask = 3;
#if MK_PER_PHASE
    for (int p = 0; p < N_PHASES; ++p) { const int nrep = (p == MK_DUP_A || p == MK_DUP_B) ? 2 : 1;
        for (int r = 0; r < nrep; ++r) { a.ph_lo = p; a.ph_hi = p + 1; a.att_mask = (r + 1 == nrep) ? 3 : MK_DUP_ATT; hipLaunchKernelGGL(mega_fwd, dim3(grid), dim3(NTHREADS), LDS_BYTES, stream, a); } }
#else
    a.ph_lo = 0; a.ph_hi = N_PHASES;
    void* kargs[] = {&a};
    hipError_t e = hipLaunchCooperativeKernel((const void*)mega_fwd, dim3(grid), dim3(NTHREADS), kargs, LDS_BYTES, stream);
    if (e != hipSuccess) fprintf(stderr, "kernel_launch: cooperative launch failed: %s (grid %d)\n", hipGetErrorString(e), grid);
#endif
}
```

```cpp
#include <hip/hip_runtime.h>
#include <hip/hip_cooperative_groups.h>
#include <cstdio>
#include <cstdint>
#include <cmath>
namespace cg = cooperative_groups;
namespace pg8 {
#define PG8_LAS __attribute__((address_space(3)))
typedef unsigned short bf16_t;
typedef short bf16x8 __attribute__((ext_vector_type(8)));
typedef float f32x4 __attribute__((ext_vector_type(4)));
typedef unsigned u32x4 __attribute__((ext_vector_type(4)));
constexpr int BM = 256, BK = 64, HALF = 128, HTB = HALF * BK * 2  , STAGE_BYTES = 8 * HTB, NXCD = 8, WGM = 8;

__host__ __device__ __forceinline__ int lds_byte(int r, int c) { const int st = (r >> 4) * 2 + (c >> 5), rr = r & 15, cc = c & 31, ob = rr * 64 + cc * 2; return st * 1024 + (ob ^ (((ob >> 9) & 1) << 5)); }
__host__ __device__ __forceinline__ void stage_rc(int b, int& R, int& C) { const int st = b / 1024, sb = b % 1024, swz = sb ^ (((sb >> 9) & 1) << 5); R = (st >> 1) * 16 + swz / 64; C = (st & 1) * 32 + (swz % 64) / 2; }
__host__ __device__ __forceinline__ int perm32(int rho) { const int n = rho >> 4, i = rho & 15; return 8 * (i >> 2) + 4 * n + (i & 3); }

struct Unit { int pm, pn; };
struct Gemm { const bf16_t* A; const bf16_t* Bt; int M, N, K; };

struct StaticOrder {
    int nM, nN, nwg, G, c;
    __host__ __device__ void init(int M, int N, int G_, int c_) { nM = M / BM; nN = N / BM; nwg = nM * nN; G = G_; c = c_; }
    __host__ __device__ bool next(int i, Unit& u) const {
        const long L = (long)i * G + c; if (L >= nwg) return false;
        int wgid = (int)L; { const int q = nwg / NXCD, r = nwg % NXCD, xcd = wgid % NXCD, off = wgid / NXCD; wgid = (xcd < r ? xcd * (q + 1) : r * (q + 1) + (xcd - r) * q) + off; }
        const int nig = WGM * nN, gid = wgid / nig, fm = gid * WGM, gsz = (nM - fm) < WGM ? (nM - fm) : WGM;
        u.pm = fm + ((wgid % nig) % gsz); u.pn = (wgid % nig) / gsz; return true;
    }
    __device__ __forceinline__ void a_ready(const Unit&) const {}
    __device__ __forceinline__ void done(const Unit&) const {}
};

__device__ __forceinline__ unsigned cvt_pk_bf16(float lo, float hi) { unsigned r; asm volatile("v_cvt_pk_bf16_f32 %0, %1, %2" : "=v"(r) : "v"(lo), "v"(hi)); return r; }
typedef float f32x2 __attribute__((ext_vector_type(2)));
__device__ __forceinline__ f32x2 gelu_pk(f32x2 v) {
    const f32x2 av = __builtin_elementwise_abs(v), d = av * 0.2316418882f + 1.0f;
    f32x2 t; t.x = __builtin_amdgcn_rcpf(d.x); t.y = __builtin_amdgcn_rcpf(d.y);
    f32x2 q = t * 0.5307027145f + (-0.7265760135f); q = q * t + 0.7107068705f; q = q * t + (-0.142248368f); q = q * t + 0.127414796f; q = q * t;
    const f32x2 s = (v * v) * (-0.72134752044f);
    f32x2 e; e.x = __builtin_amdgcn_exp2f(s.x); e.y = __builtin_amdgcn_exp2f(s.y);
    const f32x2 m = v * (q * e), r = v - m;
    f32x2 o; o.x = v.x < 0.f ? m.x : r.x; o.y = v.y < 0.f ? m.y : r.y; return o;
}

template <int ACT  > struct EpiBf16 {
    static constexpr bool PERM = true, AFTER_DRAIN = false; static_assert(ACT == 0 || ACT == 1, "EpiBf16: ACT is 0 (none) or 1 (gelu_pk)");
    bf16_t* O; int ldc; const float* bias; int split_cols; size_t split_stride; float scale0;
    __device__ __forceinline__ void operator()(const f32x4 (&acc)[2][2][4][2], const Unit& u, int wr, int wc, int fr, int fq) const {
        const int row0 = u.pm * BM + wr * 64 + fr; int colt = u.pn * BM; bf16_t* base = O;
        float sc = 1.f; if (split_cols) { const int t = colt / split_cols; base += (size_t)t * split_stride; colt -= t * split_cols; if (t == 0) sc = scale0; }
        const int col0 = colt + wc * 32 + 8 * fq, bcol0 = u.pn * BM + wc * 32 + 8 * fq;
        f32x4 bv[2][2];
#pragma unroll
        for (int bj = 0; bj < 2; ++bj)
#pragma unroll
            for (int n = 0; n < 2; ++n) bv[bj][n] = bias ? *(const f32x4*)(bias + bcol0 + bj * HALF + 4 * n) : (f32x4){0.f, 0.f, 0.f, 0.f};
#pragma unroll
        for (int ai = 0; ai < 2; ++ai)
#pragma unroll
            for (int m = 0; m < 4; ++m) { bf16_t* rowp = base + (size_t)(row0 + ai * HALF + m * 16) * ldc + col0;
#pragma unroll
                for (int bj = 0; bj < 2; ++bj) { f32x4 v0 = acc[ai][bj][m][0] + bv[bj][0], v1 = acc[ai][bj][m][1] + bv[bj][1];
                    if (ACT == 1) { f32x2 a = gelu_pk((f32x2){v0[0], v0[1]}), b = gelu_pk((f32x2){v0[2], v0[3]}), c = gelu_pk((f32x2){v1[0], v1[1]}), d = gelu_pk((f32x2){v1[2], v1[3]});
                        v0 = (f32x4){a.x, a.y, b.x, b.y}; v1 = (f32x4){c.x, c.y, d.x, d.y}; }
                    v0 = v0 * sc; v1 = v1 * sc; u32x4 w; w.x = cvt_pk_bf16(v0[0], v0[1]); w.y = cvt_pk_bf16(v0[2], v0[3]); w.z = cvt_pk_bf16(v1[0], v1[1]); w.w = cvt_pk_bf16(v1[2], v1[3]);
                    *(u32x4*)(rowp + bj * HALF) = w; } }
    }
};
struct EpiSwiglu {
    static constexpr bool PERM = true, AFTER_DRAIN = false;
    bf16_t* O; int ldc; const float* rstd;
    __device__ __forceinline__ static float silu_mul(float g, float u) { return g * __builtin_amdgcn_rcpf(1.0f + __builtin_amdgcn_exp2f(g * -1.4426950408889634f)) * u; }
    __device__ __forceinline__ void operator()(const f32x4 (&acc)[2][2][4][2], const Unit& u, int wr, int wc, int fr, int fq) const {
        const int row0 = u.pm * BM + wr * 64 + fr; const int col0 = u.pn * HALF + wc * 32 + 8 * fq;
#pragma unroll
        for (int ai = 0; ai < 2; ++ai)
#pragma unroll
            for (int m = 0; m < 4; ++m) { bf16_t* rowp = O + (size_t)(row0 + ai * HALF + m * 16) * ldc + col0; const float rs = rstd[row0 + ai * HALF + m * 16];
                const f32x4 g0 = acc[ai][0][m][0] * rs, g1 = acc[ai][0][m][1] * rs, u0 = acc[ai][1][m][0] * rs, u1 = acc[ai][1][m][1] * rs;
                u32x4 w; w.x = cvt_pk_bf16(silu_mul(g0[0], u0[0]), silu_mul(g0[1], u0[1])); w.y = cvt_pk_bf16(silu_mul(g0[2], u0[2]), silu_mul(g0[3], u0[3]));
                w.z = cvt_pk_bf16(silu_mul(g1[0], u1[0]), silu_mul(g1[1], u1[1])); w.w = cvt_pk_bf16(silu_mul(g1[2], u1[2]), silu_mul(g1[3], u1[3]));
                *(u32x4*)rowp = w; }
    }
};
struct EpiF32 {
    static constexpr bool PERM = true, AFTER_DRAIN = false;
    float* O; int ldc;
    __device__ __forceinline__ void operator()(const f32x4 (&acc)[2][2][4][2], const Unit& u, int wr, int wc, int fr, int fq) const {
        const int row0 = u.pm * BM + wr * 64 + fr; const int col0 = u.pn * BM + wc * 32 + 8 * fq;
#pragma unroll
        for (int ai = 0; ai < 2; ++ai)
#pragma unroll
            for (int m = 0; m < 4; ++m) { float* rowp = O + (size_t)(row0 + ai * HALF + m * 16) * ldc + col0;
#pragma unroll
                for (int bj = 0; bj < 2; ++bj) { *(f32x4*)(rowp + bj * HALF) = acc[ai][bj][m][0]; *(f32x4*)(rowp + bj * HALF + 4) = acc[ai][bj][m][1]; } }
    }
};
struct EpiProj {
    static constexpr bool PERM = true, AFTER_DRAIN = false;
    bf16_t* O; int ldc; float qscale; const float* rstd;
    __device__ __forceinline__ void operator()(const f32x4 (&acc)[2][2][4][2], const Unit& u, int wr, int wc, int fr, int fq) const {
        const int row0 = u.pm * BM + wr * 64 + fr; const int col0 = u.pn * BM + wc * 32 + 8 * fq;
        const float sc = (u.pn < 2 || u.pn == 6 || u.pn == 7) ? qscale : 1.0f;
#pragma unroll
        for (int ai = 0; ai < 2; ++ai)
#pragma unroll
            for (int m = 0; m < 4; ++m) { bf16_t* rowp = O + (size_t)(row0 + ai * HALF + m * 16) * ldc + col0; const float rs = sc * rstd[row0 + ai * HALF + m * 16];
#pragma unroll
                for (int bj = 0; bj < 2; ++bj) { const f32x4 v0 = acc[ai][bj][m][0] * rs, v1 = acc[ai][bj][m][1] * rs;
                    u32x4 w; w.x = cvt_pk_bf16(v0[0], v0[1]); w.y = cvt_pk_bf16(v0[2], v0[3]); w.z = cvt_pk_bf16(v1[0], v1[1]); w.w = cvt_pk_bf16(v1[2], v1[3]);
                    *(u32x4*)(rowp + bj * HALF) = w; } }
    }
};
template <class Epi, class Sched, bool ALIGN_EPI = false, bool SP2 = false>
__device__ __forceinline__ void gemm_phase(PG8_LAS unsigned char* lds, const Gemm g, const Sched& S, const Epi& E) {
    const int tid = threadIdx.x, wid = __builtin_amdgcn_readfirstlane(tid >> 6), lane = tid & 63, wr = wid >> 2, wc = wid & 3, fr = lane & 15, fq = lane >> 4;
    const int K = g.K, nt = K / BK;
    unsigned voffA[2], voffB[2];
#pragma unroll
    for (int i = 0; i < 2; ++i) { int R, C; stage_rc(tid * 16 + i * 8192, R, C); const int Rb = Epi::PERM ? ((R & ~31) + perm32(R & 31)) : R;
        voffA[i] = (unsigned)(R * K + C) * 2u; voffB[i] = (unsigned)(Rb * K + C) * 2u; }
    const size_t kstep = (size_t)(BK * 2);
    const size_t hstep = (size_t)HALF * K * 2;
    const size_t tstep = 2 * hstep;
    const unsigned ldsw = (unsigned)wid * 1024u;
    const int aoff = lds_byte(wr * 64 + fr, fq * 8), boff = lds_byte(wc * 32 + fr, fq * 8);
#define PG8_SA(b, h) (((b) * 2 + (h)) * HTB)
#define PG8_SB(b, h) ((4 + (b) * 2 + (h)) * HTB)
#define PG8_STAGE(bufoff, gbase, voff) do { _Pragma("unroll") for (int _i = 0; _i < 2; ++_i) \
        __builtin_amdgcn_global_load_lds((const unsigned*)((const char*)(gbase) + (voff)[_i]), (PG8_LAS unsigned*)(lds + (bufoff) + ldsw + _i * 8192), 16, 0, 0); } while (0)
#define PG8_LDA(dst, b, h) do { _Pragma("unroll") for (int m = 0; m < 4; ++m) _Pragma("unroll") for (int k = 0; k < 2; ++k) dst[m][k] = *(const PG8_LAS bf16x8*)(lds + PG8_SA(b, h) + aoff + m * 2048 + k * 1024); } while (0)
#define PG8_LDB(dst, b, h) do { _Pragma("unroll") for (int n = 0; n < 2; ++n) _Pragma("unroll") for (int k = 0; k < 2; ++k) dst[n][k] = *(const PG8_LAS bf16x8*)(lds + PG8_SB(b, h) + boff + n * 2048 + k * 1024); } while (0)
#define PG8_MMA(ai, bj, At, Bt) do { __builtin_amdgcn_s_setprio(1); _Pragma("unroll") for (int m = 0; m < 4; ++m) _Pragma("unroll") for (int n = 0; n < 2; ++n) _Pragma("unroll") for (int k = 0; k < 2; ++k) \
        acc[ai][bj][m][n] = __builtin_amdgcn_mfma_f32_16x16x32_bf16(Bt[n][k], At[m][k], acc[ai][bj][m][n], 0, 0, 0); __builtin_amdgcn_s_setprio(0); } while (0)
#define PG8_WAIT_V(n) asm volatile("s_waitcnt vmcnt(" #n ")" ::: "memory")
#define PG8_WAIT_L(n) asm volatile("s_waitcnt lgkmcnt(" #n ")" ::: "memory")
#define PG8_BAR __builtin_amdgcn_s_barrier()
#define PG8_SCHED __builtin_amdgcn_sched_barrier(0)
    Unit cur, nxt; int ui = 0;
    if (!S.next(0, cur)) return;
    f32x4 acc[2][2][4][2];
#pragma unroll
    for (int a = 0; a < 2; ++a)
#pragma unroll
        for (int b = 0; b < 2; ++b)
#pragma unroll
            for (int m = 0; m < 4; ++m)
#pragma unroll
                for (int n = 0; n < 2; ++n) acc[a][b][m][n] = (f32x4){0.f, 0.f, 0.f, 0.f};
    bf16x8 At[4][2], B0[2][2], B1[2][2];
    const char* cA = (const char*)g.A + (size_t)cur.pm * tstep; const char* cB = (const char*)g.Bt + (size_t)cur.pn * tstep;
    S.a_ready(cur);
    if constexpr (SP2) {
        PG8_STAGE(PG8_SB(0, 0), cB, voffB); PG8_STAGE(PG8_SB(0, 1), cB + hstep, voffB); PG8_STAGE(PG8_SA(0, 0), cA, voffA); PG8_STAGE(PG8_SA(0, 1), cA + hstep, voffA);
        if (wr == 1) PG8_BAR;
        PG8_WAIT_V(2); PG8_BAR;
        PG8_STAGE(PG8_SB(1, 0), cB + kstep, voffB); PG8_STAGE(PG8_SA(1, 0), cA + kstep, voffA); PG8_STAGE(PG8_SB(1, 1), cB + hstep + kstep, voffB);
        PG8_WAIT_V(6); PG8_BAR;
    } else {
        PG8_STAGE(PG8_SB(0, 0), cB, voffB); PG8_STAGE(PG8_SA(0, 0), cA, voffA); PG8_STAGE(PG8_SB(0, 1), cB + hstep, voffB); PG8_STAGE(PG8_SA(0, 1), cA + hstep, voffA);
        if (wr == 1) PG8_BAR;
        PG8_WAIT_V(4); PG8_BAR;
        PG8_STAGE(PG8_SB(1, 0), cB + kstep, voffB); PG8_STAGE(PG8_SA(1, 0), cA + kstep, voffA); PG8_STAGE(PG8_SB(1, 1), cB + hstep + kstep, voffB);
        PG8_WAIT_V(6); PG8_BAR;
    }
    for (;;) {
        const bool has_next = S.next(ui + 1, nxt);
        const char* nA = has_next ? (const char*)g.A + (size_t)nxt.pm * tstep : cA; const char* nB = has_next ? (const char*)g.Bt + (size_t)nxt.pn * tstep : cB;
        for (int t = 0; t < nt; t += 2) {
            const bool last = (t == nt - 2);
            const char* a1 = cA + (size_t)(t + 1) * kstep;
            const char* a2 = last ? nA : cA + (size_t)(t + 2) * kstep; const char* b2 = last ? nB : cB + (size_t)(t + 2) * kstep;
            const char* a3 = a2 + kstep; const char* b3 = b2 + kstep;
            if (last && has_next) S.a_ready(nxt);
            if constexpr (SP2) {
            PG8_LDB(B0, 0, 0); PG8_LDB(B1, 0, 1); PG8_SCHED; PG8_LDA(At, 0, 0); PG8_STAGE(PG8_SA(1, 1), a1 + hstep, voffA);
            PG8_WAIT_V(8); PG8_WAIT_L(0); PG8_BAR; PG8_MMA(0, 0, At, B0); PG8_MMA(0, 1, At, B1); PG8_BAR; PG8_SCHED;
            PG8_LDA(At, 0, 1); PG8_STAGE(PG8_SB(0, 0), b2, voffB); PG8_STAGE(PG8_SB(0, 1), b2 + hstep, voffB); PG8_STAGE(PG8_SA(0, 0), a2, voffA);
            PG8_WAIT_V(8); PG8_WAIT_L(0); PG8_BAR; PG8_MMA(1, 0, At, B0); PG8_MMA(1, 1, At, B1); PG8_BAR; PG8_SCHED;
            PG8_LDB(B0, 1, 0); PG8_LDB(B1, 1, 1); PG8_SCHED; PG8_LDA(At, 1, 0); PG8_STAGE(PG8_SA(0, 1), a2 + hstep, voffA);
            PG8_WAIT_V(8); PG8_WAIT_L(0); PG8_BAR; PG8_MMA(0, 0, At, B0); PG8_MMA(0, 1, At, B1); PG8_BAR; PG8_SCHED;
            PG8_LDA(At, 1, 1); PG8_STAGE(PG8_SB(1, 0), b3, voffB); PG8_STAGE(PG8_SB(1, 1), b3 + hstep, voffB); PG8_STAGE(PG8_SA(1, 0), a3, voffA);
            PG8_WAIT_V(8); PG8_WAIT_L(0); PG8_BAR; PG8_MMA(1, 0, At, B0); PG8_MMA(1, 1, At, B1); PG8_BAR; PG8_SCHED;
            } else {
            PG8_LDB(B0, 0, 0); PG8_SCHED; PG8_LDA(At, 0, 0); PG8_STAGE(PG8_SA(1, 1), a1 + hstep, voffA);
            PG8_WAIT_L(8); PG8_BAR; PG8_WAIT_L(0); PG8_MMA(0, 0, At, B0); PG8_BAR; PG8_SCHED;
            PG8_LDB(B1, 0, 1); PG8_STAGE(PG8_SB(0, 0), b2, voffB);
            PG8_BAR; PG8_WAIT_L(0); PG8_MMA(0, 1, At, B1); PG8_BAR;
            PG8_LDA(At, 0, 1); PG8_STAGE(PG8_SA(0, 0), a2, voffA);
            PG8_BAR; PG8_WAIT_L(0); PG8_MMA(1, 0, At, B0); PG8_BAR; PG8_SCHED;
            PG8_STAGE(PG8_SB(0, 1), b2 + hstep, voffB);
            PG8_WAIT_V(6); PG8_BAR; PG8_MMA(1, 1, At, B1); PG8_BAR;
            PG8_LDB(B0, 1, 0); PG8_SCHED; PG8_LDA(At, 1, 0); PG8_STAGE(PG8_SA(0, 1), a2 + hstep, voffA);
            PG8_WAIT_L(8); PG8_BAR; PG8_WAIT_L(0); PG8_MMA(0, 0, At, B0); PG8_BAR; PG8_SCHED;
            PG8_LDB(B1, 1, 1); PG8_STAGE(PG8_SB(1, 0), b3, voffB);
            PG8_BAR; PG8_WAIT_L(0); PG8_MMA(0, 1, At, B1); PG8_BAR;
            PG8_LDA(At, 1, 1); PG8_STAGE(PG8_SA(1, 0), a3, voffA);
            PG8_BAR; PG8_WAIT_L(0); PG8_MMA(1, 0, At, B0); PG8_BAR; PG8_SCHED;
            PG8_STAGE(PG8_SB(1, 1), b3 + hstep, voffB);
            PG8_WAIT_V(6); PG8_BAR; PG8_MMA(1, 1, At, B1); PG8_BAR;
            }
        }
        if constexpr (ALIGN_EPI) { if (wr == 0) PG8_BAR; }
        if constexpr (!Epi::AFTER_DRAIN) { E(acc, cur, wr, wc, fr, fq); S.done(cur); }
        if (!has_next) break;
#pragma unroll
        for (int a = 0; a < 2; ++a)
#pragma unroll
            for (int b = 0; b < 2; ++b)
#pragma unroll
                for (int m = 0; m < 4; ++m)
#pragma unroll
                    for (int n = 0; n < 2; ++n) acc[a][b][m][n] = (f32x4){0.f, 0.f, 0.f, 0.f};
        cur = nxt; cA = nA; cB = nB; ++ui;
        if constexpr (ALIGN_EPI) { if (wr == 1) PG8_BAR; }
    }
    PG8_WAIT_V(0);
    if constexpr (!ALIGN_EPI) { if (wr == 0) PG8_BAR; }
    PG8_BAR;
    if constexpr (Epi::AFTER_DRAIN) { E.fused(acc, cur, wr, wc, fr, fq, lds, wid, lane); S.done(cur); }
#undef PG8_SA
#undef PG8_SB
#undef PG8_STAGE
#undef PG8_LDA
#undef PG8_LDB
#undef PG8_MMA
#undef PG8_WAIT_V
#undef PG8_WAIT_L
#undef PG8_BAR
#undef PG8_SCHED
}
}

constexpr int NTOK = 32768, DM = 1024, DFF = 2816, NGU = 2 * DFF, NPROJ = 3072, SEQ = 2048, NBATCH = 16;
constexpr float RMS_EPS = 1e-6f;
constexpr int NWAVES = 8, NTHREADS = 512;
constexpr int LDS_BYTES = 147456;
constexpr size_t MiB = 1u << 20;
constexpr size_t WS_W1GU = 0, WS_W1D = 12 * MiB, WS_W2GU = 18 * MiB, WS_W2D = 30 * MiB, WS_WIN = 36 * MiB, WS_WOUT = 42 * MiB;
constexpr size_t WS_XN = 48 * MiB;
constexpr size_t WS_H = 112 * MiB;
constexpr size_t WS_X1 = 308 * MiB;
constexpr size_t WS_HO = 436 * MiB;
constexpr size_t WS_CTL = 500 * MiB;
constexpr size_t WS_END = 501 * MiB;
constexpr int PROJ_PITCH = 3072 + 64;
constexpr size_t OUT_OP = 0;
constexpr size_t OUT_LSE = 96 * MiB;

#define LAS __attribute__((address_space(3)))
typedef unsigned short bf16;
typedef float f32x4 __attribute__((ext_vector_type(4)));
typedef float f32x16 __attribute__((ext_vector_type(16)));
typedef short bf16x8 __attribute__((ext_vector_type(8)));
typedef short s16x4 __attribute__((ext_vector_type(4)));
typedef unsigned u32x4 __attribute__((ext_vector_type(4)));
typedef unsigned u32x2 __attribute__((ext_vector_type(2)));

__device__ __forceinline__ unsigned cvtpk(float lo, float hi) { typedef float f2 __attribute__((ext_vector_type(2))); typedef __bf16 b2 __attribute__((ext_vector_type(2))); f2 v = {lo, hi}; b2 b = __builtin_convertvector(v, b2); return __builtin_bit_cast(unsigned, b); }
__device__ __forceinline__ float wave_sum(float v) {
#pragma unroll
    for (int o = 1; o < 64; o <<= 1) v += __shfl_xor(v, o);
    return v;
}

__device__ __forceinline__ void transpose_item(const float* W, const float* gk, int K, int N, bf16* WT, int rowbase, int k0, int n0, LAS float* scr, int lane) {
#pragma unroll 16
    for (int i = 0; i < 32; ++i) { const int kk = 2 * i + (lane >> 5); const float gg = gk ? gk[k0 + kk] : 1.0f; scr[kk * 33 + (lane & 31)] = W[(size_t)(k0 + kk) * N + n0 + (lane & 31)] * gg; }
    asm volatile("s_waitcnt lgkmcnt(0)" ::: "memory");
    const int c = lane & 7;
#pragma unroll
    for (int j = 0; j < 4; ++j) { const int n = (lane >> 3) + 8 * j; const LAS float* s = scr + (8 * c) * 33 + n;
        u32x4 o; o.x = cvtpk(s[0 * 33], s[1 * 33]); o.y = cvtpk(s[2 * 33], s[3 * 33]); o.z = cvtpk(s[4 * 33], s[5 * 33]); o.w = cvtpk(s[6 * 33], s[7 * 33]);
        *(u32x4*)(WT + (size_t)(rowbase + n) * K + k0 + 8 * c) = o; }
    asm volatile("s_waitcnt lgkmcnt(0)" ::: "memory");
}
__device__ __forceinline__ void transpose_matrix_item(const float* W, const float* gk, int K, int N, bf16* WT, int mode, int item, LAS float* scr, int lane) {
    const int nblk = N / 32, kb = item / nblk, nb = item % nblk, k0 = 64 * kb, n0 = 32 * nb;
    const int rowbase = (mode == 0) ? n0 : ((n0 >> 7) * 256 + (n0 & 127) + (mode == 2 ? 128 : 0));
    transpose_item(W, gk, K, N, WT, rowbase, k0, n0, scr, lane);
}
__device__ __forceinline__ void row_to_bf16_rstd(const float* xrow, bf16* orow, float* rstd, int lane) {
    const f32x4* xr = (const f32x4*)xrow + lane;
    f32x4 v[4]; float s = 0.f;
#pragma unroll
    for (int j = 0; j < 4; ++j) { v[j] = xr[64 * j]; s += (v[j].x * v[j].x + v[j].y * v[j].y) + (v[j].z * v[j].z + v[j].w * v[j].w); }
    const float r = 1.0f / sqrtf(wave_sum(s) * (1.0f / DM) + RMS_EPS);
    u32x2* o8 = (u32x2*)orow + lane;
#pragma unroll
    for (int j = 0; j < 4; ++j) { u32x2 w; w.x = cvtpk(v[j].x, v[j].y); w.y = cvtpk(v[j].z, v[j].w); o8[64 * j] = w; }
    if (lane == 0) *rstd = r;
}
__device__ __forceinline__ f32x4 bf4_to_f32(u32x2 w) { return (f32x4){__uint_as_float(w.x << 16), __uint_as_float(w.x & 0xffff0000u), __uint_as_float(w.y << 16), __uint_as_float(w.y & 0xffff0000u)}; }
template <bool XF32, bool OF32>
__device__ __forceinline__ void residual_row(const bf16* hrow, const void* xin, const float* gpost, float coef, void* xout, float* rstd, int lane) {
    const u32x2* hr = (const u32x2*)hrow + lane; const f32x4* gr = (const f32x4*)gpost + lane;
    f32x4 hv[4], xv[4]; float s = 0.f;
#pragma unroll
    for (int j = 0; j < 4; ++j) { hv[j] = bf4_to_f32(hr[64 * j]);
        if (XF32) xv[j] = ((const f32x4*)xin + lane)[64 * j]; else xv[j] = bf4_to_f32(((const u32x2*)xin + lane)[64 * j]);
        s += (hv[j].x * hv[j].x + hv[j].y * hv[j].y) + (hv[j].z * hv[j].z + hv[j].w * hv[j].w); }
    const float r = coef / sqrtf(wave_sum(s) * (1.0f / DM) + RMS_EPS);
    float s2 = 0.f;
#pragma unroll
    for (int j = 0; j < 4; ++j) { const f32x4 gg = gr[64 * j]; xv[j] = xv[j] + hv[j] * gg * r; s2 += (xv[j].x * xv[j].x + xv[j].y * xv[j].y) + (xv[j].z * xv[j].z + xv[j].w * xv[j].w); }
    if (OF32) {
        f32x4* xo = (f32x4*)xout + lane;
#pragma unroll
        for (int j = 0; j < 4; ++j) xo[64 * j] = xv[j];
    } else {
        u32x2* o8 = (u32x2*)xout + lane;
#pragma unroll
        for (int j = 0; j < 4; ++j) { u32x2 w; w.x = cvtpk(xv[j].x, xv[j].y); w.y = cvtpk(xv[j].z, xv[j].w); o8[64 * j] = w; }
        const float r2 = 1.0f / sqrtf(wave_sum(s2) * (1.0f / DM) + RMS_EPS);
        if (lane == 0) *rstd = r2;
    }
}

namespace att {
constexpr int PITCH = PROJ_PITCH;
constexpr int KSTR = 272, VSTR = 320;
constexpr int KT = 64 * KSTR, VT = 64 * VSTR, STAGE = KT + VT;
constexpr int XCH_OFF = 2 * STAGE;
static_assert(XCH_OFF + 65536 <= LDS_BYTES, "attention LDS map");
#define MFMA32(a, b, c) __builtin_amdgcn_mfma_f32_32x32x16_bf16((a), (b), (c), 0, 0, 0)

struct Unit {
    const bf16* q; const bf16* k; const bf16* v;
    int dil, res, q0, t_lo, t_hi;
    float slope2d;
};

template <bool DIFF>
__device__ __forceinline__ void sub_block(const LAS unsigned char* kp, const LAS unsigned char* vp, int dq, float sl, const bf16x8 (&qf)[4],
                                          f32x16 (&o)[DIFF ? 4 : 2], float& m, float& l, bool& started, int r32, int h) {
    constexpr int NDV = DIFF ? 4 : 2;
    constexpr float THR = 6.0f;
    if (dq > 31) return;
    if (!DIFF && (-dq - 31 > 128)) return;
    f32x16 s; const float base = sl * (float)(dq + 8 * h - r32) - m;
#pragma unroll
    for (int i = 0; i < 16; ++i) s[i] = sl * (float)((i & 7) + 16 * (i >> 3)) + base;
    bf16x8 kf[4];
#pragma unroll
    for (int kk = 0; kk < 4; ++kk) kf[kk] = *(const LAS bf16x8*)(kp + kk * 32);
    __builtin_amdgcn_sched_barrier(0);
#pragma unroll
    for (int kk = 0; kk < 4; ++kk) s = MFMA32(kf[kk], qf[kk], s);
    const bool need_mask = (dq + 31 > 0) || (!DIFF && (31 - dq > 128));
    if (need_mask) {
#pragma unroll
        for (int i = 0; i < 16; ++i) { const int rel = dq + ((i & 7) + 8 * h + 16 * (i >> 3)) - r32;
            const bool valid = (rel <= 0) && (DIFF || rel >= -128); s[i] = valid ? s[i] : -INFINITY; }
    }
    float mx = fmaxf(fmaxf(s[0], s[1]), s[2]);
#pragma unroll
    for (int i = 3; i < 15; i += 2) mx = fmaxf(fmaxf(mx, s[i]), s[i + 1]);
    mx = fmaxf(mx, s[15]);
    mx = fmaxf(mx, __shfl_xor(mx, 32));
    if (!started || __any(mx > THR)) {
        const float delta = started ? fmaxf(mx, 0.f) : mx;
#pragma unroll
        for (int i = 0; i < 16; ++i) s[i] -= delta;
        m += delta;
        if (started) { const float alpha = __builtin_amdgcn_exp2f(-delta); l *= alpha;
#pragma unroll
            for (int d = 0; d < NDV; ++d)
#pragma unroll
                for (int i = 0; i < 16; ++i) o[d][i] *= alpha; }
        started = true;
    }
    float ps = 0.f;
#pragma unroll
    for (int i = 0; i < 16; ++i) { s[i] = __builtin_amdgcn_exp2f(s[i]); ps += s[i]; }
    l += ps;
    u32x4 p0, p1;
    p0.x = cvtpk(s[0], s[1]); p0.y = cvtpk(s[2], s[3]); p0.z = cvtpk(s[4], s[5]); p0.w = cvtpk(s[6], s[7]);
    p1.x = cvtpk(s[8], s[9]); p1.y = cvtpk(s[10], s[11]); p1.z = cvtpk(s[12], s[13]); p1.w = cvtpk(s[14], s[15]);
    const bf16x8 pf0 = __builtin_bit_cast(bf16x8, p0), pf1 = __builtin_bit_cast(bf16x8, p1);
    typedef short v4i16_t __attribute__((ext_vector_type(4)));
#pragma unroll
    for (int d = 0; d < NDV; ++d) {
#pragma unroll
        for (int ss = 0; ss < 2; ++ss) {
            const LAS unsigned char* a = vp + ss * 16 * VSTR + d * 64;
            const s16x4 lo = __builtin_bit_cast(s16x4, __builtin_amdgcn_ds_read_tr16_b64_v4i16((LAS v4i16_t*)(a)));
            const s16x4 hi = __builtin_bit_cast(s16x4, __builtin_amdgcn_ds_read_tr16_b64_v4i16((LAS v4i16_t*)(a + 4 * VSTR)));
            const bf16x8 vf = __builtin_shufflevector(lo, hi, 0, 1, 2, 3, 4, 5, 6, 7);
            o[d] = MFMA32(vf, ss == 0 ? pf0 : pf1, o[d]);
        }
    }
}

__device__ __forceinline__ void tile_full(const LAS unsigned char* kp, const LAS unsigned char* vp, int dq, float sl, const bf16x8 (&qf)[4],
                                          f32x16 (&o)[4], float& m, float& l, int r32, int h) {
    constexpr float THR = 6.0f;
    typedef short v4i16_t __attribute__((ext_vector_type(4)));
    bf16x8 k0[4];
#pragma unroll
    for (int kk = 0; kk < 4; ++kk) k0[kk] = *(const LAS bf16x8*)(kp + kk * 32);
    f32x16 s0, s1; const float base0 = sl * (float)(dq + 8 * h - r32) - m, base1 = base0 + sl * 32.0f;
#pragma unroll
    for (int i = 0; i < 16; ++i) { const float ci = sl * (float)((i & 7) + 16 * (i >> 3)); s0[i] = ci + base0; s1[i] = ci + base1; }
    __builtin_amdgcn_sched_barrier(0);
    bf16x8 k1[4];
#pragma unroll
    for (int kk = 0; kk < 4; ++kk) { k1[kk] = *(const LAS bf16x8*)(kp + 32 * KSTR + kk * 32); s0 = MFMA32(k0[kk], qf[kk], s0); }
#pragma unroll
    for (int kk = 0; kk < 4; ++kk) s1 = MFMA32(k1[kk], qf[kk], s1);
    float mx = fmaxf(fmaxf(s0[0], s0[1]), s1[0]);
    mx = fmaxf(fmaxf(mx, s1[1]), s0[2]);
#pragma unroll
    for (int i = 3; i < 15; i += 2) { mx = fmaxf(fmaxf(mx, s0[i]), s0[i + 1]); mx = fmaxf(fmaxf(mx, s1[i - 1]), s1[i]); }
    mx = fmaxf(fmaxf(mx, s0[15]), fmaxf(s1[14], s1[15]));
    mx = fmaxf(mx, __shfl_xor(mx, 32));
    if (!__any(mx > -134.0f)) return;
    if (__any(mx > THR)) {
        const float delta = fmaxf(mx, 0.f);
#pragma unroll
        for (int i = 0; i < 16; ++i) { s0[i] -= delta; s1[i] -= delta; }
        m += delta;
        const float alpha = __builtin_amdgcn_exp2f(-delta); l *= alpha;
#pragma unroll
        for (int d = 0; d < 4; ++d)
#pragma unroll
            for (int i = 0; i < 16; ++i) o[d][i] *= alpha;
    }
    float ps0 = 0.f, ps1 = 0.f;
#pragma unroll
    for (int i = 0; i < 16; ++i) { s0[i] = __builtin_amdgcn_exp2f(s0[i]); ps0 += s0[i]; }
#pragma unroll
    for (int i = 0; i < 16; ++i) { s1[i] = __builtin_amdgcn_exp2f(s1[i]); ps1 += s1[i]; }
    l += ps0 + ps1;
    u32x4 pw[4];
    pw[0].x = cvtpk(s0[0], s0[1]); pw[0].y = cvtpk(s0[2], s0[3]); pw[0].z = cvtpk(s0[4], s0[5]); pw[0].w = cvtpk(s0[6], s0[7]);
    pw[1].x = cvtpk(s0[8], s0[9]); pw[1].y = cvtpk(s0[10], s0[11]); pw[1].z = cvtpk(s0[12], s0[13]); pw[1].w = cvtpk(s0[14], s0[15]);
    pw[2].x = cvtpk(s1[0], s1[1]); pw[2].y = cvtpk(s1[2], s1[3]); pw[2].z = cvtpk(s1[4], s1[5]); pw[2].w = cvtpk(s1[6], s1[7]);
    pw[3].x = cvtpk(s1[8], s1[9]); pw[3].y = cvtpk(s1[10], s1[11]); pw[3].z = cvtpk(s1[12], s1[13]); pw[3].w = cvtpk(s1[14], s1[15]);
#pragma unroll
    for (int d = 0; d < 4; ++d) {
#pragma unroll
        for (int ks = 0; ks < 4; ++ks) {
            const LAS unsigned char* a = vp + ks * 16 * VSTR + d * 64;
            const s16x4 lo = __builtin_bit_cast(s16x4, __builtin_amdgcn_ds_read_tr16_b64_v4i16((LAS v4i16_t*)(a)));
            const s16x4 hi = __builtin_bit_cast(s16x4, __builtin_amdgcn_ds_read_tr16_b64_v4i16((LAS v4i16_t*)(a + 4 * VSTR)));
            const bf16x8 vf = __builtin_shufflevector(lo, hi, 0, 1, 2, 3, 4, 5, 6, 7);
            o[d] = MFMA32(vf, __builtin_bit_cast(bf16x8, pw[ks]), o[d]);
        }
        if (d & 1) __builtin_amdgcn_sched_barrier(0);
    }
}

template <bool DIFF>
__device__ __forceinline__ void attn_unit(LAS unsigned char* lds, const Unit& U, int tokbase, bf16* outp, float* lsep, float lam, const float* gsub, float post, int flags) {
    constexpr int NDV = DIFF ? 4 : 2;
    int tid = threadIdx.x; asm volatile("" : "+v"(tid));
    const int lane = tid & 63, wid = __builtin_amdgcn_readfirstlane(tid >> 6), rg = wid & 3, c = wid >> 2, r32 = lane & 31, h = lane >> 5;
    const int qidx = U.q0 + 32 * rg;
    const bf16* qrow = U.q + (size_t)(U.res + (qidx + r32) * U.dil) * PITCH + c * 64 + 8 * h;
    bf16x8 qf[4];
#pragma unroll
    for (int kk = 0; kk < 4; ++kk) qf[kk] = *(const bf16x8*)(qrow + 16 * kk);
    f32x16 o[NDV];
#pragma unroll
    for (int d = 0; d < NDV; ++d)
#pragma unroll
        for (int i = 0; i < 16; ++i) o[d][i] = 0.f;
    float m = 0.f, l = 0.f; bool started = false;
    const float sl = U.slope2d;
    const int srow0 = tid >> 4, sch = tid & 15;
    const size_t tstep = (size_t)64 * U.dil * PITCH;
    const bf16* gk0 = U.k + (size_t)(U.res + (64 * U.t_lo + srow0) * U.dil) * PITCH + sch * 8;
    const bf16* gv0 = U.v + (size_t)(U.res + (64 * U.t_lo + srow0) * U.dil) * PITCH + sch * 8;
    const size_t rstep32 = (size_t)32 * U.dil * PITCH;
    const int lk0 = srow0 * KSTR + sch * 16, lv0 = KT + srow0 * VSTR + sch * 16;
    const int pi = (r32 & 0x13) | (((r32 >> 3) & 1) << 2) | (((r32 >> 2) & 1) << 3);
    const int koffb = pi * KSTR + (c * 64 + 8 * h) * 2;
    const int i16 = lane & 15, q4 = i16 >> 2, p4 = i16 & 3, blk = (lane >> 4) & 1;
    const int voffb = KT + (8 * h + q4) * VSTR + ((DIFF ? 0 : c * 64) + 16 * blk + 4 * p4) * 2;

    __syncthreads();
    const int nt = U.t_hi - U.t_lo;
    u32x4 rk0, rk1, rv0, rv1;
    { const bf16* gk = gk0 + (size_t)(nt - 1) * tstep; const bf16* gv = gv0 + (size_t)(nt - 1) * tstep;
      rk0 = *(const u32x4*)gk; rk1 = *(const u32x4*)(gk + rstep32); rv0 = *(const u32x4*)gv; rv1 = *(const u32x4*)(gv + rstep32); }
    *(LAS u32x4*)(lds + lk0) = rk0; *(LAS u32x4*)(lds + lk0 + 32 * KSTR) = rk1; *(LAS u32x4*)(lds + lv0) = rv0; *(LAS u32x4*)(lds + lv0 + 32 * VSTR) = rv1;
    __syncthreads();
    for (int j = 0; j < nt; ++j) {
        const int tt = nt - 1 - j;
        const int cur = (j & 1) * STAGE; const bool more = (j + 1 < nt);
        if (more && !(flags & 4)) { const bf16* gk = gk0 + (size_t)(tt - 1) * tstep; const bf16* gv = gv0 + (size_t)(tt - 1) * tstep;
            rk0 = *(const u32x4*)gk; rk1 = *(const u32x4*)(gk + rstep32); rv0 = *(const u32x4*)gv; rv1 = *(const u32x4*)(gv + rstep32); }
        const int dq = 64 * (U.t_lo + tt) - qidx;
        if (flags & 8) {} else if (DIFF && j >= 2) {
            if constexpr (DIFF) tile_full(lds + cur + koffb, lds + cur + voffb, dq, sl, qf, o, m, l, r32, h);
        } else {
            sub_block<DIFF>(lds + cur + koffb + 32 * KSTR, lds + cur + voffb + 32 * VSTR, dq + 32, sl, qf, o, m, l, started, r32, h);
            sub_block<DIFF>(lds + cur + koffb, lds + cur + voffb, dq, sl, qf, o, m, l, started, r32, h);
        }
        if (more && !(flags & 4)) { const int nx = STAGE - cur;
            *(LAS u32x4*)(lds + nx + lk0) = rk0; *(LAS u32x4*)(lds + nx + lk0 + 32 * KSTR) = rk1; *(LAS u32x4*)(lds + nx + lv0) = rv0; *(LAS u32x4*)(lds + nx + lv0 + 32 * VSTR) = rv1; }
        __syncthreads();
    }
    const float lt = l + __shfl_xor(l, 32);
    const float inv = 1.0f / lt;
    const int tok = tokbase + U.res + (qidx + r32) * U.dil;
    if (DIFF) {
        LAS float* xch = (LAS float*)(lds + XCH_OFF) + rg * 4096 + lane;
        if (c == 1) { const float f = inv * lam;
#pragma unroll
            for (int d = 0; d < NDV; ++d)
#pragma unroll
                for (int i = 0; i < 16; ++i) xch[(d * 16 + i) * 64] = o[d][i] * f; }
        __syncthreads();
        if (c == 0) {
            float ss = 0.f;
#pragma unroll
            for (int d = 0; d < NDV; ++d)
#pragma unroll
                for (int i = 0; i < 16; ++i) { const float v = o[d][i] * inv - xch[(d * 16 + i) * 64]; o[d][i] = v; ss += v * v; }
            ss += __shfl_xor(ss, 32);
            const float r = post / sqrtf(ss * (1.0f / 128.0f) + RMS_EPS);
            bf16* orow = outp + (size_t)tok * DM;
#pragma unroll
            for (int d = 0; d < NDV; ++d)
#pragma unroll
                for (int g = 0; g < 4; ++g) { const int dv = 32 * d + 8 * g + 4 * h; const f32x4 gg = *(const f32x4*)(gsub + dv);
                    u32x2 w; w.x = cvtpk(o[d][4 * g] * r * gg.x, o[d][4 * g + 1] * r * gg.y); w.y = cvtpk(o[d][4 * g + 2] * r * gg.z, o[d][4 * g + 3] * r * gg.w);
                    *(u32x2*)(orow + dv) = w; }
        }
    } else {
        LAS unsigned char* st = lds + wid * 4608;
#pragma unroll
        for (int d = 0; d < NDV; ++d)
#pragma unroll
            for (int g = 0; g < 4; ++g) { const int dv = 32 * d + 8 * g + 4 * h;
                u32x2 w; w.x = cvtpk(o[d][4 * g] * inv, o[d][4 * g + 1] * inv); w.y = cvtpk(o[d][4 * g + 2] * inv, o[d][4 * g + 3] * inv);
                *(LAS u32x2*)(st + r32 * 144 + dv * 2) = w; }
#pragma unroll
        for (int i = 0; i < 4; ++i) { const int row = i * 8 + (lane >> 3), ch = lane & 7;
            const u32x4 v = *(const LAS u32x4*)(st + row * 144 + ch * 16);
            *(u32x4*)(outp + (size_t)(tokbase + U.res + (qidx + row) * U.dil) * 512 + c * 64 + ch * 8) = v; }
        if (h == 0) lsep[(size_t)tok * 8 + c] = m + __builtin_log2f(lt);
    }
}

constexpr int WSLOT = 32768;
static_assert(4 * WSLOT <= LDS_BYTES - 64, "dilated window LDS map");
struct Seq { const bf16* q; const bf16* k; const bf16* v; int dil, res, n0, cnt; float slope2d; bf16* outp; float* lsep; int tokbase; };

template <int DQ>
__device__ __forceinline__ void sub_block_w(const LAS unsigned char* krow, int kx, int kch, const LAS unsigned char* vrow, int vg0, float sl, const bf16x8 (&qf)[4],
                                            f32x16 (&o)[2], float& m, float& l, bool& started, int r32, int h) {
    constexpr float THR = 6.0f;
    typedef short v4i16_t __attribute__((ext_vector_type(4)));
    f32x16 s; const float base = sl * (float)(DQ + 8 * h - r32) - m;
#pragma unroll
    for (int i = 0; i < 16; ++i) s[i] = sl * (float)((i & 7) + 16 * (i >> 3)) + base;
    bf16x8 kf[4];
#pragma unroll
    for (int kk = 0; kk < 4; ++kk) kf[kk] = *(const LAS bf16x8*)(krow + (((kch + 2 * kk) ^ kx) << 4));
#pragma unroll
    for (int kk = 0; kk < 4; ++kk) s = MFMA32(kf[kk], qf[kk], s);
    constexpr bool need_mask = (DQ + 31 > 0) || (31 - DQ > 128);
    if (need_mask) {
#pragma unroll
        for (int i = 0; i < 16; ++i) { const int rel = DQ + ((i & 7) + 8 * h + 16 * (i >> 3)) - r32;
            const bool valid = (rel <= 0) && (rel >= -128); s[i] = valid ? s[i] : -INFINITY; }
    }
    float mx = fmaxf(fmaxf(s[0], s[1]), s[2]);
#pragma unroll
    for (int i = 3; i < 15; i += 2) mx = fmaxf(fmaxf(mx, s[i]), s[i + 1]);
    mx = fmaxf(mx, s[15]);
    mx = fmaxf(mx, __shfl_xor(mx, 32));
    if (!started || __any(mx > THR)) {
        const float delta = started ? fmaxf(mx, 0.f) : mx;
#pragma unroll
        for (int i = 0; i < 16; ++i) s[i] -= delta;
        m += delta;
        if (started) { const float alpha = __builtin_amdgcn_exp2f(-delta); l *= alpha;
#pragma unroll
            for (int d = 0; d < 2; ++d)
#pragma unroll
                for (int i = 0; i < 16; ++i) o[d][i] *= alpha; }
        started = true;
    }
    float ps = 0.f;
#pragma unroll
    for (int i = 0; i < 16; ++i) { s[i] = __builtin_amdgcn_exp2f(s[i]); ps += s[i]; }
    l += ps;
    u32x4 p0, p1;
    p0.x = cvtpk(s[0], s[1]); p0.y = cvtpk(s[2], s[3]); p0.z = cvtpk(s[4], s[5]); p0.w = cvtpk(s[6], s[7]);
    p1.x = cvtpk(s[8], s[9]); p1.y = cvtpk(s[10], s[11]); p1.z = cvtpk(s[12], s[13]); p1.w = cvtpk(s[14], s[15]);
    const bf16x8 pf0 = __builtin_bit_cast(bf16x8, p0), pf1 = __builtin_bit_cast(bf16x8, p1);
#pragma unroll
    for (int d = 0; d < 2; ++d) {
#pragma unroll
        for (int ss = 0; ss < 2; ++ss) {
            const LAS unsigned char* a = vrow + ss * 4096 + (vg0 ^ (d * 64));
            const s16x4 lo = __builtin_bit_cast(s16x4, __builtin_amdgcn_ds_read_tr16_b64_v4i16((LAS v4i16_t*)(a)));
            const s16x4 hi = __builtin_bit_cast(s16x4, __builtin_amdgcn_ds_read_tr16_b64_v4i16((LAS v4i16_t*)(a + 1024)));
            const bf16x8 vf = __builtin_shufflevector(lo, hi, 0, 1, 2, 3, 4, 5, 6, 7);
            o[d] = MFMA32(vf, ss == 0 ? pf0 : pf1, o[d]);
        }
    }
}

__device__ __forceinline__ void dil_sequence(LAS unsigned char* lds, const Seq& S) {
    int tid = threadIdx.x; asm volatile("" : "+v"(tid));
    const int lane = tid & 63, wid = __builtin_amdgcn_readfirstlane(tid >> 6), rg = wid & 3, c = wid >> 2, r32 = lane & 31, h = lane >> 5;
    const int srow = tid >> 4, sch = tid & 15;
    const int lkw = srow * 256 + ((sch ^ (srow & 15)) << 4);
    const int lvw = 16384 + srow * 256 + ((sch ^ ((srow & 3) << 2)) << 4);
    const size_t rowp = (size_t)S.dil * PITCH;
    const bf16* gk = S.k + (size_t)(S.res + srow * S.dil) * PITCH + sch * 8;
    const bf16* gv = S.v + (size_t)(S.res + srow * S.dil) * PITCH + sch * 8;
    const int pi = (r32 & 0x13) | (((r32 >> 3) & 1) << 2) | (((r32 >> 2) & 1) << 3);
    const int kx = pi & 15, kch = c * 8 + h, krow_off = pi * 256;
    const int i16 = lane & 15, q4 = i16 >> 2, p4 = i16 & 3, blk = (lane >> 4) & 1;
    const int vrow_off = 16384 + (8 * h + q4) * 256 + 32 * blk + 8 * p4, vg0 = ((2 * c) ^ q4) * 64;
    u32x4 r0, r1, r2, r3, r4, r5, r6, r7;
#define DW_LOAD2(T) do { const bf16* k_ = gk + (size_t)(64 * (T)) * rowp; const bf16* v_ = gv + (size_t)(64 * (T)) * rowp; \
        r0 = *(const u32x4*)k_; r1 = *(const u32x4*)(k_ + 32 * rowp); r2 = *(const u32x4*)v_; r3 = *(const u32x4*)(v_ + 32 * rowp); \
        r4 = *(const u32x4*)(k_ + 64 * rowp); r5 = *(const u32x4*)(k_ + 96 * rowp); r6 = *(const u32x4*)(v_ + 64 * rowp); r7 = *(const u32x4*)(v_ + 96 * rowp); } while (0)
#define DW_WRITE2(T) do { LAS unsigned char* a_ = lds + ((T) & 3) * WSLOT; LAS unsigned char* b_ = lds + (((T) + 1) & 3) * WSLOT; \
        *(LAS u32x4*)(a_ + lkw) = r0; *(LAS u32x4*)(a_ + lkw + 8192) = r1; *(LAS u32x4*)(a_ + lvw) = r2; *(LAS u32x4*)(a_ + lvw + 8192) = r3; \
        *(LAS u32x4*)(b_ + lkw) = r4; *(LAS u32x4*)(b_ + lkw + 8192) = r5; *(LAS u32x4*)(b_ + lvw) = r6; *(LAS u32x4*)(b_ + lvw + 8192) = r7; } while (0)
    const bf16* qbase = S.q + (size_t)(S.res + (32 * rg + r32) * S.dil) * PITCH + c * 64 + 8 * h;
    bf16x8 qf[4], qn[4];
    __syncthreads();
    if (S.n0 > 0) { DW_LOAD2(2 * S.n0 - 2); DW_WRITE2(2 * S.n0 - 2); }
    DW_LOAD2(2 * S.n0);
#pragma unroll
    for (int kk = 0; kk < 4; ++kk) qf[kk] = *(const bf16x8*)(qbase + (size_t)(128 * S.n0) * rowp + 16 * kk);
    DW_WRITE2(2 * S.n0);
    __syncthreads();
    for (int bi = 0; bi < S.cnt; ++bi) {
        const int n = S.n0 + bi; const bool more = (bi + 1 < S.cnt);
        if (more) { DW_LOAD2(2 * n + 2);
#pragma unroll
            for (int kk = 0; kk < 4; ++kk) qn[kk] = *(const bf16x8*)(qbase + (size_t)(128 * (n + 1)) * rowp + 16 * kk); }
        f32x16 o[2];
#pragma unroll
        for (int d = 0; d < 2; ++d)
#pragma unroll
            for (int i = 0; i < 16; ++i) o[d][i] = 0.f;
        float m = 0.f, l = 0.f; bool started = false;
        const int kb0 = 128 * n - 128 + 32 * rg;
#define DW_SUB(J) do { const int kb_ = kb0 + 32 * (J); if (kb_ >= 0) { const LAS unsigned char* sl_ = lds + ((kb_ >> 6) & 3) * WSLOT + ((kb_ >> 5) & 1) * 8192; \
            sub_block_w<-128 + 32 * (J)>(sl_ + krow_off, kx, kch, sl_ + vrow_off, vg0, S.slope2d, qf, o, m, l, started, r32, h); } } while (0)
        DW_SUB(4); DW_SUB(3); DW_SUB(2); DW_SUB(1); DW_SUB(0);
#undef DW_SUB
        const float lt = l + __shfl_xor(l, 32);
        const float inv = 1.0f / lt;
        const int tok = S.tokbase + S.res + (128 * n + 32 * rg + r32) * S.dil;
        bf16* orow = S.outp + (size_t)tok * 512 + c * 64;
#pragma unroll
        for (int d = 0; d < 2; ++d)
#pragma unroll
            for (int g = 0; g < 4; ++g) { const int dv = 32 * d + 8 * g + 4 * h;
                u32x2 w; w.x = cvtpk(o[d][4 * g] * inv, o[d][4 * g + 1] * inv); w.y = cvtpk(o[d][4 * g + 2] * inv, o[d][4 * g + 3] * inv);
                *(u32x2*)(orow + dv) = w; }
        if (h == 0) S.lsep[(size_t)tok * 8 + c] = m + __builtin_log2f(lt);
        if (more) {
            __syncthreads();
            DW_WRITE2(2 * n + 2);
#pragma unroll
            for (int kk = 0; kk < 4; ++kk) qf[kk] = qn[kk];
            __syncthreads();
        }
    }
#undef DW_LOAD2
#undef DW_WRITE2
}
}

#define XB_TMO      128
#define XB_XCNT(j)  (256  + 64 * (j))
#define XB_XSUB(j)  (1280 + 64 * (j))
#define XB_XGEN(j)  (2304 + 64 * (j))
#define XB_TOP      3328
#define XB_TOPGEN   3392
#define XCD_BAR_WORDS 3456
#define XB_SPIN_CAP (1u << 18)

__device__ __forceinline__ unsigned xb_ld(unsigned* p)              { return __hip_atomic_load(p, __ATOMIC_RELAXED, __HIP_MEMORY_SCOPE_AGENT); }
__device__ __forceinline__ unsigned xb_add(unsigned* p, unsigned v) { return __hip_atomic_fetch_add(p, v, __ATOMIC_RELAXED, __HIP_MEMORY_SCOPE_AGENT); }
__device__ __forceinline__ unsigned xb_xcc_id() { return (unsigned)__builtin_amdgcn_s_getreg((3 << 11) | 20) & 0xFu; }
#define XB_SPIN(cond, bar) do { unsigned _sp = 0; while (cond) { __builtin_amdgcn_s_sleep(1); \
    if ((++_sp & 255u) == 0u) { if (xb_ld(&(bar)[XB_TMO])) break; if (_sp > XB_SPIN_CAP) { atomicAdd(&(bar)[XB_TMO], 1u); break; } } } } while (0)

struct XcdBarrier {
    unsigned* bar; unsigned x;
    volatile LAS unsigned* st;
};

__device__ __forceinline__ XcdBarrier xcd_barrier_post(unsigned* bar, volatile LAS unsigned* st) {
    XcdBarrier b; b.bar = bar; b.x = xb_xcc_id(); b.st = st;
    if (threadIdx.x == 0) (void)xb_add(&bar[XB_XCNT(b.x)], 1u);
    return b;
}
__device__ __forceinline__ void xcd_barrier_complete(unsigned* bar, unsigned x, unsigned& nloc, unsigned& nx) {
    const unsigned G = gridDim.x * gridDim.y * gridDim.z;
    unsigned sum, cnt, mine, sp = 0u;
    for (;;) {
        sum = 0u; cnt = 0u; mine = 0u;
#pragma unroll
        for (unsigned j = 0; j < 16; ++j) { const unsigned c = xb_ld(&bar[XB_XCNT(j)]); sum += c; cnt += (c > 0u) ? 1u : 0u; mine = (j == x) ? c : mine; }
        if (sum == G) break;
        __builtin_amdgcn_s_sleep(1);
        if ((++sp & 255u) == 0u) { if (xb_ld(&bar[XB_TMO])) break; if (sp > XB_SPIN_CAP) { atomicAdd(&bar[XB_TMO], 1u); break; } }
    }
    nloc = mine > 0u ? mine : 1u; nx = cnt > 0u ? cnt : 1u;
}

__device__ __forceinline__ void xcd_barrier(const XcdBarrier& b) {
    asm volatile("s_waitcnt vmcnt(0)" ::: "memory");
    __syncthreads();
    if (threadIdx.x == 0) {
        unsigned* bar = b.bar;
        __builtin_amdgcn_s_waitcnt(0);
        unsigned nloc = b.st[0], nx = b.st[1];
        if (nloc == 0u) { xcd_barrier_complete(bar, b.x, nloc, nx); b.st[0] = nloc; b.st[1] = nx; }
        const unsigned old = xb_add(&bar[XB_XSUB(b.x)], 1u);
        const unsigned gen = old / nloc;
        if (old + 1u == (gen + 1u) * nloc) {
            __builtin_amdgcn_fence(__ATOMIC_RELEASE, "agent");
            asm volatile("s_waitcnt vmcnt(0)" ::: "memory");
            const unsigned og = xb_add(&bar[XB_TOP], 1u);
            const unsigned tg = og / nx;
            if (og + 1u == (tg + 1u) * nx) xb_add(&bar[XB_TOPGEN], 1u);
            else XB_SPIN(xb_ld(&bar[XB_TOPGEN]) == tg, bar);
            __builtin_amdgcn_fence(__ATOMIC_ACQUIRE, "agent");
            xb_add(&bar[XB_XGEN(b.x)], 1u);
            asm volatile("s_waitcnt vmcnt(0)" ::: "memory");
        } else {
            XB_SPIN(xb_ld(&bar[XB_XGEN(b.x)]) == gen, bar);
            __builtin_amdgcn_fence(__ATOMIC_ACQUIRE, "agent");
            asm volatile("s_waitcnt vmcnt(0)" ::: "memory");
        }
    }
    __syncthreads();
}


struct Args { const float* in[20]; float* out; unsigned char* ws; int ph_lo, ph_hi, att_mask, pad; };
constexpr int N_PHASES = 12;

__global__ void __launch_bounds__(NTHREADS, 2) mega_fwd(Args args) {
    extern __shared__ __attribute__((aligned(16))) unsigned char lds_raw[];
    LAS unsigned char* lds = (LAS unsigned char*)lds_raw;
    cg::grid_group grid = cg::this_grid();
    const int G = gridDim.x, bx = blockIdx.x, NGW = G * NWAVES;
#define PHASE_IDS int tid = threadIdx.x; asm volatile("" : "+v"(tid)); const int lane = tid & 63, wave = __builtin_amdgcn_readfirstlane(tid >> 6), gw = bx * NWAVES + wave; (void)lane; (void)gw;
    unsigned char* ws = args.ws;
    const float* x = args.in[0];
    bf16* W1GU = (bf16*)(ws + WS_W1GU); bf16* W1D = (bf16*)(ws + WS_W1D); bf16* W2GU = (bf16*)(ws + WS_W2GU); bf16* W2D = (bf16*)(ws + WS_W2D);
    bf16* WIN = (bf16*)(ws + WS_WIN); bf16* WOUT = (bf16*)(ws + WS_WOUT);
    bf16* XN = (bf16*)(ws + WS_XN); bf16* HB = (bf16*)(ws + WS_H); bf16* MIXB = (bf16*)(ws + WS_X1); float* RSTD = (float*)(ws + WS_X1 + 64 * MiB);
    bf16* HO = (bf16*)(ws + WS_HO);
    unsigned* CTL = (unsigned*)(ws + WS_CTL);
    volatile LAS unsigned* MISC = (volatile LAS unsigned*)(lds + LDS_BYTES - 64);
    if (threadIdx.x < 16) MISC[threadIdx.x] = 0u;
    __syncthreads();
    XcdBarrier bar; bar.bar = CTL; bar.x = 0; bar.st = MISC;
    bf16* OP = (bf16*)((unsigned char*)args.out + OUT_OP); float* LSE = (float*)((unsigned char*)args.out + OUT_LSE);
    const int lo = args.ph_lo, hi = args.ph_hi;
#define IN(k) (lo <= (k) && (k) < hi)
#define SEAM(k) do { if (IN(k) && IN((k) + 1)) { if ((k) == 0) { grid.sync(); bar = xcd_barrier_post(CTL, MISC); } else xcd_barrier(bar); } } while (0)

    if (IN(0)) {
        PHASE_IDS
        if (bx == 0) for (int i = tid; i < XCD_BAR_WORDS; i += NTHREADS) CTL[i] = 0u;
        LAS float* scr = (LAS float*)(lds + wave * 16384);
        constexpr int I_G = (DM / 64) * (DFF / 32), I_D = (DFF / 64) * (DM / 32), I_IN = (DM / 64) * (NPROJ / 32), I_OUT = (DM / 64) * (DM / 32);
        constexpr int NITEMS = 6 * I_G + I_IN + I_OUT;
        static_assert(I_G == I_D, "item counts");
        for (int it = gw; it < NITEMS; it += NGW) {
            int r = it;
            if (r < I_G) { transpose_matrix_item(args.in[2], args.in[1], DM, DFF, W1GU, 1, r, scr, lane); continue; } r -= I_G;
            if (r < I_G) { transpose_matrix_item(args.in[3], args.in[1], DM, DFF, W1GU, 2, r, scr, lane); continue; } r -= I_G;
            if (r < I_D) { transpose_matrix_item(args.in[4], nullptr, DFF, DM, W1D, 0, r, scr, lane); continue; } r -= I_D;
            if (r < I_G) { transpose_matrix_item(args.in[16], args.in[15], DM, DFF, W2GU, 1, r, scr, lane); continue; } r -= I_G;
            if (r < I_G) { transpose_matrix_item(args.in[17], args.in[15], DM, DFF, W2GU, 2, r, scr, lane); continue; } r -= I_G;
            if (r < I_D) { transpose_matrix_item(args.in[18], nullptr, DFF, DM, W2D, 0, r, scr, lane); continue; } r -= I_D;
            if (r < I_IN) { transpose_matrix_item(args.in[7], args.in[6], DM, NPROJ, WIN, 0, r, scr, lane); continue; } r -= I_IN;
            transpose_matrix_item(args.in[13], nullptr, DM, DM, WOUT, 0, r, scr, lane);
        }
        for (int mrow = gw; mrow < NTOK; mrow += NGW) row_to_bf16_rstd(x + (size_t)mrow * DM, XN + (size_t)mrow * DM, RSTD + mrow, lane);
        __syncthreads();
    }
    SEAM(0);
    if (IN(1)) { pg8::Gemm g{XN, W1GU, NTOK, NGU, DM}; pg8::StaticOrder S; S.init(NTOK, NGU, G, bx); pg8::EpiSwiglu E{HB, DFF, RSTD};
        pg8::gemm_phase<pg8::EpiSwiglu, pg8::StaticOrder, true, true>(lds, g, S, E); }
    SEAM(1);
    if (IN(2)) { pg8::Gemm g{HB, W1D, NTOK, DM, DFF}; pg8::StaticOrder S; S.init(NTOK, DM, G, bx); pg8::EpiBf16<0> E{HO, DM, nullptr, 0, 0, 1.f};
        pg8::gemm_phase<pg8::EpiBf16<0>, pg8::StaticOrder, true, true>(lds, g, S, E); }
    SEAM(2);
    if (IN(3)) { PHASE_IDS for (int mrow = gw; mrow < NTOK; mrow += NGW) { const size_t o = (size_t)mrow * DM; residual_row<true, false>(HO + o, x + o, args.in[5], 0.5f, XN + o, RSTD + mrow, lane); } }
    SEAM(3);
    if (IN(4)) { pg8::Gemm g{XN, WIN, NTOK, NPROJ, DM}; pg8::StaticOrder S; S.init(NTOK, NPROJ, G, bx); pg8::EpiProj E{HB, PROJ_PITCH, 0.125f * 1.4426950408889634f, RSTD};
        pg8::gemm_phase<pg8::EpiProj, pg8::StaticOrder, true, true>(lds, g, S, E); }
    SEAM(4);
    if (IN(5)) {
        PHASE_IDS
        bf16* MIX = MIXB;
        float lam;
        { const float a = (lane < 64) ? args.in[8][lane] * args.in[9][lane] : 0.f, b = args.in[10][lane] * args.in[11][lane];
          lam = __expf(wave_sum(a)) - __expf(wave_sum(b)) + 0.2f; }
        const float LOG2E = 1.4426950408889634f;
        const int xcd = bx & 7, wl = bx >> 3, nwx = (G - xcd + 7) >> 3;
        if (args.att_mask & 1) for (int v = wl, jr = 0; v < 128; v += nwx, ++jr) {
            const int bh = 8 * xcd + 4 * ((v >> 4) & 1) + (v >> 5), i16 = v & 15, b = bh >> 2, hd = bh & 3;
            const float slope = exp2f(-8.0f * (float)(3 * hd + 1) / 12.0f);
            {
                const int qb = (jr & 1) ? 15 - i16 : i16;
                att::Unit U; const bf16* base = HB + (size_t)b * SEQ * PROJ_PITCH;
                U.q = base + hd * 128; U.k = base + 512 + hd * 128; U.v = base + 1024 + hd * 128;
                U.dil = 1; U.res = 0; U.q0 = 128 * qb; U.t_lo = 0; U.t_hi = 2 * qb + 2; U.slope2d = slope * LOG2E;
                att::attn_unit<true>(lds, U, b * SEQ, MIX + hd * 128, nullptr, lam, args.in[12], 0.8f, args.att_mask);
            }
        }
        if (args.att_mask & 2) for (int sidx = wl; sidx < 32; sidx += nwx) {
            const int setl = sidx >> 2, i4 = sidx & 3, bh = 8 * xcd + setl, b = bh >> 2, hp = bh & 3;
            const int cw = wave >> 2, head = 2 * hp + cw, aidx = head + 1 + (head >> 1);
            const float slope = exp2f(-8.0f * (float)(aidx + 1) / 12.0f) * LOG2E;
            const bf16* base = HB + (size_t)b * SEQ * PROJ_PITCH;
            att::Seq S; S.q = base + 1536 + hp * 128; S.k = base + 2048 + hp * 128; S.v = base + 2560 + hp * 128; S.tokbase = b * SEQ;
            S.dil = 1; S.res = 0; S.n0 = 4 * i4; S.cnt = 4; S.slope2d = slope; S.outp = OP + hp * 128; S.lsep = LSE + hp * 2;
            att::dil_sequence(lds, S);
            S.dil = 4; S.res = i4; S.n0 = 0; S.cnt = 4; S.slope2d = slope * 4.0f; S.outp = OP + (size_t)NTOK * 512 + hp * 128; S.lsep = LSE + (size_t)NTOK * 8 + hp * 2;
            att::dil_sequence(lds, S);
            for (int j = 0; j < 4; ++j) {
                S.dil = 16; S.res = 4 * i4 + j; S.n0 = 0; S.cnt = 1; S.slope2d = slope * 16.0f; S.outp = OP + (size_t)2 * NTOK * 512 + hp * 128; S.lsep = LSE + (size_t)2 * NTOK * 8 + hp * 2;
                att::dil_sequence(lds, S);
            }
        }
    }
    SEAM(5);
    if (IN(6)) {
        PHASE_IDS
        bf16* MIX = MIXB;
        const int nth = G * NTHREADS;
        for (int it = bx * NTHREADS + tid; it < NTOK * 64; it += nth) {
            const int tok = it >> 6, hc = it & 63, head = hc >> 3;
            const float l0 = LSE[(size_t)tok * 8 + head], l1 = LSE[(size_t)NTOK * 8 + (size_t)tok * 8 + head], l2 = LSE[(size_t)2 * NTOK * 8 + (size_t)tok * 8 + head];
            const float mx = fmaxf(l0, fmaxf(l1, l2));
            float w0 = __builtin_amdgcn_exp2f(l0 - mx), w1 = __builtin_amdgcn_exp2f(l1 - mx), w2 = __builtin_amdgcn_exp2f(l2 - mx);
            const float iw = 1.0f / (w0 + w1 + w2); w0 *= iw; w1 *= iw; w2 *= iw;
            const u32x4 a = *(const u32x4*)(OP + (size_t)tok * 512 + hc * 8), bq = *(const u32x4*)(OP + (size_t)NTOK * 512 + (size_t)tok * 512 + hc * 8), cq = *(const u32x4*)(OP + (size_t)2 * NTOK * 512 + (size_t)tok * 512 + hc * 8);
            u32x4 r;
#pragma unroll
            for (int j = 0; j < 4; ++j) {
                const float alo = __uint_as_float(a[j] << 16), ahi = __uint_as_float(a[j] & 0xffff0000u), blo = __uint_as_float(bq[j] << 16), bhi = __uint_as_float(bq[j] & 0xffff0000u),
                            clo = __uint_as_float(cq[j] << 16), chi = __uint_as_float(cq[j] & 0xffff0000u);
                r[j] = cvtpk(w0 * alo + w1 * blo + w2 * clo, w0 * ahi + w1 * bhi + w2 * chi);
            }
            *(u32x4*)(MIX + (size_t)tok * DM + 512 + hc * 8) = r;
        }
    }
    SEAM(6);
    if (IN(7)) { pg8::Gemm g{MIXB, WOUT, NTOK, DM, DM}; pg8::StaticOrder S; S.init(NTOK, DM, G, bx); pg8::EpiBf16<0> E{HO, DM, nullptr, 0, 0, 1.f};
        pg8::gemm_phase<pg8::EpiBf16<0>, pg8::StaticOrder, true, true>(lds, g, S, E); }
    SEAM(7);
    if (IN(8)) { PHASE_IDS for (int mrow = gw; mrow < NTOK; mrow += NGW) { const size_t o = (size_t)mrow * DM; residual_row<false, false>(HO + o, XN + o, args.in[14], 1.0f, XN + o, RSTD + mrow, lane); } }
    SEAM(8);
    if (IN(9)) { pg8::Gemm g{XN, W2GU, NTOK, NGU, DM}; pg8::StaticOrder S; S.init(NTOK, NGU, G, bx); pg8::EpiSwiglu E{HB, DFF, RSTD};
        pg8::gemm_phase<pg8::EpiSwiglu, pg8::StaticOrder, true, true>(lds, g, S, E); }
    SEAM(9);
    if (IN(10)) { pg8::Gemm g{HB, W2D, NTOK, DM, DFF}; pg8::StaticOrder S; S.init(NTOK, DM, G, bx); pg8::EpiBf16<0> E{HO, DM, nullptr, 0, 0, 1.f};
        pg8::gemm_phase<pg8::EpiBf16<0>, pg8::StaticOrder, true, true>(lds, g, S, E); }
    SEAM(10);
    if (IN(11)) { PHASE_IDS for (int mrow = gw; mrow < NTOK; mrow += NGW) { const size_t o = (size_t)mrow * DM; residual_row<false, true>(HO + o, XN + o, args.in[19], 0.5f, args.out + o, nullptr, lane); } }
#undef IN
#undef SEAM
}

#ifndef MK_DUP_ATT
#define MK_DUP_ATT 3
#endif
#ifndef MK_DUP_A
#define MK_DUP_A -1
#endif
#ifndef MK_DUP_B
#define MK_DUP_B -1
#endif
#ifndef MK_PER_PHASE
#define MK_PER_PHASE 0
#endif
extern "C" void kernel_launch(void* const* d_in, const int* in_sizes, int n_in, void* d_out, int out_size, void* d_ws, size_t ws_size, hipStream_t stream) {
    static int grid = 0;
    if (grid == 0) {
        if (n_in != 20 || in_sizes[0] != NTOK * DM || out_size != NTOK * DM || ws_size < WS_END) {
            fprintf(stderr, "kernel_launch: unexpected problem (n_in %d, in0 %d, out %d, ws %zu); nothing launched\n", n_in, n_in > 0 ? in_sizes[0] : -1, out_size, ws_size); grid = -1; return; }
        int dev = 0, cus = 0, per_cu = 0;
        if (hipGetDevice(&dev) != hipSuccess || hipDeviceGetAttribute(&cus, hipDeviceAttributeMultiprocessorCount, dev) != hipSuccess) { fprintf(stderr, "kernel_launch: device query failed\n"); grid = -1; return; }
        if (hipFuncSetAttribute((const void*)mega_fwd, hipFuncAttributeMaxDynamicSharedMemorySize, LDS_BYTES) != hipSuccess) { fprintf(stderr, "kernel_launch: hipFuncSetAttribute failed\n"); grid = -1; return; }
        if (hipOccupancyMaxActiveBlocksPerMultiprocessor(&per_cu, (const void*)mega_fwd, NTHREADS, LDS_BYTES) != hipSuccess || per_cu < 1) { fprintf(stderr, "kernel_launch: occupancy query says %d\n", per_cu); per_cu = 1; }
        (void)hipGetLastError();
        grid = cus;
    }
    if (grid < 0) return;
    Args a{};
    for (int i = 0; i < 20; ++i) a.in[i] = (const float*)d_in[i];
    a.out = (float*)d_out; a.ws = (unsigned char*)d_ws; a.att_mask = 3;
#if MK_PER_PHASE
    for (int p = 0; p < N_PHASES; ++p) { const int nrep = (p == MK_DUP_A || p == MK_DUP_B) ? 2 : 1;
        for (int r = 0; r < nrep; ++r) { a.ph_lo = p; a.ph_hi = p + 1; a.att_mask = (r + 1 == nrep) ? 3 : MK_DUP_ATT; hipLaunchKernelGGL(mega_fwd, dim3(grid), dim3(NTHREADS), LDS_BYTES, stream, a); } }
#else
    a.ph_lo = 0; a.ph_hi = N_PHASES;
    void* kargs[] = {&a};
    hipError_t e = hipLaunchCooperativeKernel((const void*)mega_fwd, dim3(grid), dim3(NTHREADS), kargs, LDS_BYTES, stream);
    if (e != hipSuccess) fprintf(stderr, "kernel_launch: cooperative launch failed: %s (grid %d)\n", hipGetErrorString(e), grid);
#endif
}
```
